# Optimizing an MI355X kernel written in HIP

```python
import math
import jax, jax.numpy as jnp
from jax import lax
import numpy as np

D_MODEL = 1024
BATCH = 1
SEQ = 16384
DEPTH = 1

CHUNK = 64
N_MEM = 256
EPS = 1e-6

A_HEADS = 4
A_QK_DIM = 64
A_V_DIM = 2 * A_QK_DIM
A_WIDTH = A_HEADS * A_V_DIM
Q_BLOCK = 128

REL_BUCKETS = 32
REL_MAX_DIST = 128

B_HEADS = 4
B_K_DIM = 128
B_V_DIM = 128
B_WIDTH = B_HEADS * B_V_DIM
CONV_WIDTH = 4

X_HEADS = 4
X_HEAD_DIM = D_MODEL // X_HEADS

N_EXPERTS = 32
TOP_K = 4
D_FF = 1024
SWIGLU_LIMIT = 7.0
SWIGLU_ALPHA = 1.702
MOE_BLOCK = 128

IN_SPLIT_SIZES = (
    A_HEADS * 2 * A_QK_DIM,
    A_HEADS * 2 * A_QK_DIM,
    A_WIDTH,
    B_HEADS * B_K_DIM,
    B_HEADS * B_K_DIM,
    B_WIDTH,
    B_WIDTH,
    B_HEADS,
    B_HEADS,
    D_MODEL,
    D_MODEL,
)
IN_COLS = 512 + 512 + 512 + 512 + 512 + 512 + 512 + 4 + 4 + 1024 + 1024

kernel_name = "hybrid_diffattn_gdn_moe_block"


def rmsnorm(x, g):
    xf = x.astype(jnp.float32)
    y = xf * lax.rsqrt(jnp.mean(xf * xf, axis=-1, keepdims=True) + EPS)
    return (y * g.astype(jnp.float32)).astype(x.dtype)


def l2norm(t):
    return t * lax.rsqrt(jnp.sum(t * t, axis=-1, keepdims=True) + EPS)


def split_in(proj):
    idx = [int(i) for i in np.cumsum(IN_SPLIT_SIZES)[:-1]]
    return jnp.split(proj, idx, axis=-1)


def t5_bucket(rel):
    half = REL_BUCKETS // 2
    max_exact = half // 2
    ret = jnp.where(rel > 0, half, 0)
    n = jnp.abs(rel)
    large = max_exact + (jnp.log(jnp.maximum(n, 1).astype(jnp.float32) / max_exact)
                         / math.log(REL_MAX_DIST / max_exact) * (half - max_exact)).astype(jnp.int32)
    large = jnp.minimum(large, half - 1)
    return ret + jnp.where(n < max_exact, n, large)


def diff_attention(qa, ka, va, rel_bias, lam):
    B_, S_ = qa.shape[0], qa.shape[1]
    q = qa.reshape(B_, S_, A_HEADS, 2, A_QK_DIM)
    k = ka.reshape(B_, S_, A_HEADS, 2, A_QK_DIM)
    v = va.reshape(B_, S_, A_HEADS, A_V_DIM)
    nqb = S_ // Q_BLOCK
    qblocks = q.reshape(B_, nqb, Q_BLOCK, A_HEADS, 2, A_QK_DIM).swapaxes(0, 1)
    k_pos = jnp.arange(S_, dtype=jnp.int32)
    k_chunk = k_pos // CHUNK
    scale = A_QK_DIM ** -0.5

    def block(args):
        qb, bi = args
        q_pos = bi * Q_BLOCK + jnp.arange(Q_BLOCK, dtype=jnp.int32)
        logits = jnp.einsum('bqhmd,bkhmd->bhmqk', qb, k).astype(jnp.float32) * scale
        bias = rel_bias[t5_bucket(k_pos[None, :] - q_pos[:, None])].astype(jnp.float32)
        logits = logits + jnp.transpose(bias, (2, 0, 1))[None, :, None]
        mask = k_chunk[None, :] <= (q_pos // CHUNK)[:, None]
        p = jax.nn.softmax(jnp.where(mask, logits, -jnp.inf), axis=-1)
        pd = p[:, :, 0] - lam * p[:, :, 1]
        return jnp.einsum('bhqk,bkhd->bqhd', pd.astype(v.dtype), v)

    o = lax.map(block, (qblocks, jnp.arange(nqb, dtype=jnp.int32)))
    return o.swapaxes(0, 1).reshape(B_, S_, A_HEADS, A_V_DIM)


def causal_conv(x, w):
    return lax.conv_general_dilated(
        x, w[:, None, :].astype(x.dtype), window_strides=(1,), padding=[(CONV_WIDTH - 1, 0)],
        dimension_numbers=('NWC', 'WIO', 'NWC'), feature_group_count=x.shape[-1])


def chunk_gated_delta_rule(q, k, v, g, beta):
    B_, S_, H, dk = q.shape
    dv = v.shape[-1]
    N = S_ // CHUNK

    def chunks(t):
        return t.reshape(B_, N, CHUNK, H, -1).transpose(0, 3, 1, 2, 4)

    q = chunks(q) * (dk ** -0.5)
    k = chunks(k)
    v = chunks(v)
    g = g.reshape(B_, N, CHUNK, H).transpose(0, 3, 1, 2)
    beta = beta.reshape(B_, N, CHUNK, H).transpose(0, 3, 1, 2)
    gc = jnp.cumsum(g, axis=-1)
    kb = k * beta[..., None]
    vb = v * beta[..., None]
    idx = jnp.arange(CHUNK)
    incl = idx[:, None] >= idx[None, :]
    strict = idx[:, None] > idx[None, :]
    decay = jnp.exp(jnp.where(incl, gc[..., :, None] - gc[..., None, :], -jnp.inf))
    L = jnp.einsum('bhnid,bhnjd->bhnij', kb, k) * jnp.where(strict, decay, 0.0)
    tri = jnp.eye(CHUNK, dtype=jnp.float32) + L
    rhs = jnp.concatenate([vb, kb * jnp.exp(gc)[..., None]], axis=-1)
    sol = lax.linalg.triangular_solve(tri, rhs, left_side=True, lower=True)
    u, w = sol[..., :dv], sol[..., dv:]
    qk = jnp.einsum('bhnid,bhnjd->bhnij', q, k) * decay
    q_dec = q * jnp.exp(gc)[..., None]
    g_last = gc[..., -1]
    k_dec = k * jnp.exp(g_last[..., None] - gc)[..., None]

    def step(S, xs):
        u_i, w_i, qk_i, qd_i, kd_i, gl_i = xs
        v_new = u_i - jnp.einsum('bhcd,bhde->bhce', w_i, S)
        o = jnp.einsum('bhcd,bhde->bhce', qd_i, S) + jnp.einsum('bhij,bhje->bhie', qk_i, v_new)
        S = S * jnp.exp(gl_i)[..., None, None] + jnp.einsum('bhcd,bhce->bhde', kd_i, v_new)
        return S, o

    xs = tuple(jnp.moveaxis(t, 2, 0) for t in (u, w, qk, q_dec, k_dec, g_last))
    S0 = jnp.zeros((B_, H, dk, dv), jnp.float32)
    _, o = lax.scan(step, S0, xs)
    return o.transpose(1, 0, 3, 2, 4).reshape(B_, S_, H, dv)


def cross_attention(h, m, w_q, w_kv, w_o):
    B_, S_ = h.shape[0], h.shape[1]
    q = (h @ w_q).reshape(B_, S_, X_HEADS, X_HEAD_DIM)
    kv = m @ w_kv
    k = kv[..., :D_MODEL].reshape(B_, m.shape[1], X_HEADS, X_HEAD_DIM)
    v = kv[..., D_MODEL:].reshape(B_, m.shape[1], X_HEADS, X_HEAD_DIM)
    logits = jnp.einsum('bqhd,bkhd->bhqk', q, k).astype(jnp.float32) * (X_HEAD_DIM ** -0.5)
    p = jax.nn.softmax(logits, axis=-1).astype(v.dtype)
    o = jnp.einsum('bhqk,bkhd->bqhd', p, v).reshape(B_, S_, D_MODEL)
    return o @ w_o


def moe(h, w_router, b_router, w_mlp1, b_mlp1, w_mlp2, b_mlp2):
    B_, S_, D = h.shape
    T = B_ * S_
    A = T * TOP_K
    hf = h.reshape(T, D)
    logits = (hf @ w_router + b_router).astype(jnp.float32)
    top_val, top_idx = lax.top_k(logits, TOP_K)
    wts = jax.nn.softmax(top_val, axis=-1)
    e_flat = top_idx.reshape(A).astype(jnp.int32)
    tok_flat = jnp.repeat(jnp.arange(T, dtype=jnp.int32), TOP_K)
    w_flat = wts.reshape(A)
    order = jnp.argsort(e_flat, stable=True)
    se, st, sw = e_flat[order], tok_flat[order], w_flat[order]
    counts = jnp.zeros((N_EXPERTS,), jnp.int32).at[e_flat].add(1)
    start = jnp.cumsum(counts) - counts
    nblk = (counts + MOE_BLOCK - 1) // MOE_BLOCK
    blk_end = jnp.cumsum(nblk)
    blk_start = blk_end - nblk
    dest = blk_start[se] * MOE_BLOCK + (jnp.arange(A, dtype=jnp.int32) - start[se])
    NB = A // MOE_BLOCK + N_EXPERTS
    P = NB * MOE_BLOCK
    row_tok = jnp.full((P,), T, jnp.int32).at[dest].set(st)
    block_e = jnp.minimum(jnp.searchsorted(blk_end, jnp.arange(NB, dtype=jnp.int32), side='right'),
                          N_EXPERTS - 1).astype(jnp.int32)
    xs = jnp.concatenate([hf, jnp.zeros((1, D), hf.dtype)], axis=0)[row_tok].reshape(NB, MOE_BLOCK, D)

    def expert_block(args):
        xb, e = args
        hid = xb @ w_mlp1[e] + b_mlp1[e]
        glu = jnp.minimum(hid[:, :D_FF], SWIGLU_LIMIT)
        lin = jnp.clip(hid[:, D_FF:], -SWIGLU_LIMIT, SWIGLU_LIMIT)
        act = glu * jax.nn.sigmoid(SWIGLU_ALPHA * glu) * (lin + 1.0)
        return act @ w_mlp2[e] + b_mlp2[e]

    ys = lax.map(expert_block, (xs, block_e)).reshape(P, D)
    contrib = ys[dest] * sw[:, None].astype(ys.dtype)
    y = jnp.zeros((T, D), ys.dtype).at[st].add(contrib)
    return y.reshape(B_, S_, D).astype(h.dtype)


def setup_inputs(seed: int = 0) -> dict:
    key = jax.random.key(seed)
    ks = jax.random.split(key, 32)
    f32 = jnp.float32

    def nrm(k, shape, scale):
        return jax.random.normal(k, shape, f32) * scale

    def gain(k, shape):
        return 1.0 + 0.02 * jax.random.normal(k, shape, f32)

    L, D, E, F = DEPTH, D_MODEL, N_EXPERTS, D_FF
    dt = jnp.exp(jax.random.uniform(ks[10], (L, B_HEADS), f32, math.log(1e-3), math.log(1e-1)))
    return {
        "x": nrm(ks[0], (BATCH, SEQ, D), 1.0),
        "mem": nrm(ks[1], (BATCH, N_MEM, D), 1.0),
        "g_mix": gain(ks[2], (L, D)),
        "w_in": nrm(ks[3], (L, D, IN_COLS), D ** -0.5),
        "rel_bias": nrm(ks[4], (REL_BUCKETS, A_HEADS), 0.5),
        "lambda_q1": nrm(ks[5], (L, A_QK_DIM), 0.1),
        "lambda_k1": nrm(ks[6], (L, A_QK_DIM), 0.1),
        "lambda_q2": nrm(ks[7], (L, A_QK_DIM), 0.1),
        "lambda_k2": nrm(ks[8], (L, A_QK_DIM), 0.1),
        "g_subln": gain(ks[9], (L, A_V_DIM)),
        "conv_w": nrm(ks[11], (L, CONV_WIDTH, 2 * B_HEADS * B_K_DIM + B_WIDTH), CONV_WIDTH ** -0.5),
        "a_log": jnp.log(jax.random.uniform(ks[12], (L, B_HEADS), f32, 1.0, 16.0)),
        "dt_bias": dt + jnp.log(-jnp.expm1(-dt)),
        "g_out_b": gain(ks[13], (L, B_V_DIM)),
        "w_up_a": nrm(ks[14], (L, A_WIDTH, D), A_WIDTH ** -0.5),
        "w_up_b": nrm(ks[15], (L, B_WIDTH, D), B_WIDTH ** -0.5),
        "w_out": nrm(ks[16], (L, D, D), D ** -0.5),
        "g_xattn": gain(ks[17], (L, D)),
        "g_mem": gain(ks[18], (L, D)),
        "w_q_x": nrm(ks[19], (L, D, D), D ** -0.5),
        "w_kv_x": nrm(ks[20], (L, D, 2 * D), D ** -0.5),
        "w_o_x": nrm(ks[21], (L, D, D), D ** -0.5),
        "g_moe": gain(ks[22], (L, D)),
        "w_router": nrm(ks[23], (L, D, E), D ** -0.5),
        "b_router": nrm(ks[24], (L, E), 0.01),
        "w_mlp1": nrm(ks[25], (L, E, D, 2 * F), D ** -0.5),
        "b_mlp1": nrm(ks[26], (L, E, 2 * F), 0.01),
        "w_mlp2": nrm(ks[27], (L, E, F, D), F ** -0.5),
        "b_mlp2": nrm(ks[28], (L, E, D), 0.01),
        "g_final": gain(ks[29], (D,)),
    }


def reference(x, mem, g_mix, w_in, rel_bias, lambda_q1, lambda_k1, lambda_q2, lambda_k2, g_subln,
              conv_w, a_log, dt_bias, g_out_b, w_up_a, w_up_b, w_out, g_xattn, g_mem, w_q_x, w_kv_x,
              w_o_x, g_moe, w_router, b_router, w_mlp1, b_mlp1, w_mlp2, b_mlp2, g_final):
    B_, S_ = x.shape[0], x.shape[1]
    f32 = jnp.float32
    for l in range(DEPTH):
        lambda_init = 0.8 - 0.6 * math.exp(-0.3 * l)
        h = rmsnorm(x, g_mix[l])
        qa, ka, va, qb, kb, vb, zb, ab, bb, gate_a, gate_b = split_in(h @ w_in[l])

        lam = (jnp.exp(jnp.sum(lambda_q1[l].astype(f32) * lambda_k1[l].astype(f32)))
               - jnp.exp(jnp.sum(lambda_q2[l].astype(f32) * lambda_k2[l].astype(f32))) + lambda_init)
        oa = diff_attention(qa, ka, va, rel_bias, lam)
        oa = (rmsnorm(oa, g_subln[l]) * (1.0 - lambda_init)).reshape(B_, S_, A_WIDTH)

        qkv = jax.nn.silu(causal_conv(jnp.concatenate([qb, kb, vb], axis=-1), conv_w[l]))
        qc = qkv[..., :B_HEADS * B_K_DIM].reshape(B_, S_, B_HEADS, B_K_DIM).astype(f32)
        kc = qkv[..., B_HEADS * B_K_DIM:2 * B_HEADS * B_K_DIM].reshape(B_, S_, B_HEADS, B_K_DIM).astype(f32)
        vc = qkv[..., 2 * B_HEADS * B_K_DIM:].reshape(B_, S_, B_HEADS, B_V_DIM).astype(f32)
        beta = jax.nn.sigmoid(bb.astype(f32))
        g = -jnp.exp(a_log[l].astype(f32)) * jax.nn.softplus(ab.astype(f32) + dt_bias[l].astype(f32))
        ob = chunk_gated_delta_rule(l2norm(qc), l2norm(kc), vc, g, beta).astype(x.dtype)
        ob = (rmsnorm(ob, g_out_b[l]) * jax.nn.silu(zb.reshape(B_, S_, B_HEADS, B_V_DIM))).reshape(B_, S_, B_WIDTH)

        merged = jax.nn.sigmoid(gate_a) * (oa @ w_up_a[l]) + jax.nn.sigmoid(gate_b) * (ob @ w_up_b[l])
        x = x + merged @ w_out[l]

        x = x + cross_attention(rmsnorm(x, g_xattn[l]), rmsnorm(mem, g_mem[l]), w_q_x[l], w_kv_x[l], w_o_x[l])

        x = x + moe(rmsnorm(x, g_moe[l]), w_router[l], b_router[l], w_mlp1[l], b_mlp1[l], w_mlp2[l], b_mlp2[l])
    return rmsnorm(x, g_final)
```

```cpp
#include <hip/hip_runtime.h>
#include <cstdio>
#include <cstdint>
namespace pg8 {
#define PG8_LAS __attribute__((address_space(3)))
typedef unsigned short bf16_t;
typedef short bf16x8 __attribute__((ext_vector_type(8)));
typedef float f32x4 __attribute__((ext_vector_type(4)));
typedef unsigned u32x4 __attribute__((ext_vector_type(4)));
typedef int i32x8_ __attribute__((ext_vector_type(8)));
typedef short s16x16_ __attribute__((ext_vector_type(16)));
constexpr int BM = 256, BK = 64, HALF = 128, HTB = HALF * BK * 2  , STAGE_BYTES = 8 * HTB, NXCD = 8, WGM = 8;

__host__ __device__ __forceinline__ int lds_byte(int r, int c) { const int st = (r >> 4) * 2 + (c >> 5), rr = r & 15, cc = c & 31, ob = rr * 64 + cc * 2; return st * 1024 + (ob ^ (((ob >> 9) & 1) << 5)); }
__host__ __device__ __forceinline__ void stage_rc(int b, int& R, int& C) { const int st = b / 1024, sb = b % 1024, swz = sb ^ (((sb >> 9) & 1) << 5); R = (st >> 1) * 16 + swz / 64; C = (st & 1) * 32 + (swz % 64) / 2; }
__host__ __device__ __forceinline__ int perm32(int rho) { const int n = rho >> 4, i = rho & 15; return 8 * (i >> 2) + 4 * n + (i & 3); }

struct Unit { int pm, pn; };
struct Gemm { const bf16_t* A; const bf16_t* Bt; int M, N, K; const int* tok; };

struct StaticOrder {
    int nM, nN, nwg, G, c;
    __host__ __device__ void init(int M, int N, int G_, int c_) { nM = M / BM; nN = N / BM; nwg = nM * nN; G = G_; c = c_; }
    __host__ __device__ bool next(int i, Unit& u) const {
        const long L = (long)i * G + c; if (L >= nwg) return false;
        int wgid = (int)L; { const int q = nwg / NXCD, r = nwg % NXCD, xcd = wgid % NXCD, off = wgid / NXCD; wgid = (xcd < r ? xcd * (q + 1) : r * (q + 1) + (xcd - r) * q) + off; }
        const int nig = WGM * nN, gid = wgid / nig, fm = gid * WGM, gsz = (nM - fm) < WGM ? (nM - fm) : WGM;
        u.pm = fm + ((wgid % nig) % gsz); u.pn = (wgid % nig) / gsz; return true;
    }
    __device__ __forceinline__ void a_ready(const Unit&) const {}
    __device__ __forceinline__ void done(const Unit&) const {}
};

__device__ __forceinline__ unsigned cvt_pk_bf16(float lo, float hi) { unsigned r; asm volatile("v_cvt_pk_bf16_f32 %0, %1, %2" : "=v"(r) : "v"(lo), "v"(hi)); return r; }
typedef float f32x2 __attribute__((ext_vector_type(2)));
__device__ __forceinline__ f32x2 gelu_pk(f32x2 v) {
    const f32x2 av = __builtin_elementwise_abs(v), d = av * 0.2316418882f + 1.0f;
    f32x2 t; t.x = __builtin_amdgcn_rcpf(d.x); t.y = __builtin_amdgcn_rcpf(d.y);
    f32x2 q = t * 0.5307027145f + (-0.7265760135f); q = q * t + 0.7107068705f; q = q * t + (-0.142248368f); q = q * t + 0.127414796f; q = q * t;
    const f32x2 s = (v * v) * (-0.72134752044f);
    f32x2 e; e.x = __builtin_amdgcn_exp2f(s.x); e.y = __builtin_amdgcn_exp2f(s.y);
    const f32x2 m = v * (q * e), r = v - m;
    f32x2 o; o.x = v.x < 0.f ? m.x : r.x; o.y = v.y < 0.f ? m.y : r.y; return o;
}

template <int ACT  > struct EpiBf16 {
    static constexpr bool PERM = true, AFTER_DRAIN = false; static_assert(ACT == 0 || ACT == 1, "EpiBf16: ACT is 0 (none) or 1 (gelu_pk)");
    bf16_t* O; int ldc; const float* bias; int split_cols; size_t split_stride; float scale0;
    __device__ __forceinline__ void operator()(const f32x4 (&acc)[2][2][4][2], const Unit& u, int wr, int wc, int fr, int fq) const {
        const int row0 = u.pm * BM + wr * 64 + fr; int colt = u.pn * BM; bf16_t* base = O;
        float sc = 1.f; if (split_cols) { const int t = colt / split_cols; base += (size_t)t * split_stride; colt -= t * split_cols; if (t == 0) sc = scale0; }
        const int col0 = colt + wc * 32 + 8 * fq, bcol0 = u.pn * BM + wc * 32 + 8 * fq;
        f32x4 bv[2][2];
#pragma unroll
        for (int bj = 0; bj < 2; ++bj)
#pragma unroll
            for (int n = 0; n < 2; ++n) bv[bj][n] = bias ? *(const f32x4*)(bias + bcol0 + bj * HALF + 4 * n) : (f32x4){0.f, 0.f, 0.f, 0.f};
#pragma unroll
        for (int ai = 0; ai < 2; ++ai)
#pragma unroll
            for (int m = 0; m < 4; ++m) { bf16_t* rowp = base + (size_t)(row0 + ai * HALF + m * 16) * ldc + col0;
#pragma unroll
                for (int bj = 0; bj < 2; ++bj) { f32x4 v0 = acc[ai][bj][m][0] + bv[bj][0], v1 = acc[ai][bj][m][1] + bv[bj][1];
                    if (ACT == 1) { f32x2 a = gelu_pk((f32x2){v0[0], v0[1]}), b = gelu_pk((f32x2){v0[2], v0[3]}), c = gelu_pk((f32x2){v1[0], v1[1]}), d = gelu_pk((f32x2){v1[2], v1[3]});
                        v0 = (f32x4){a.x, a.y, b.x, b.y}; v1 = (f32x4){c.x, c.y, d.x, d.y}; }
                    v0 = v0 * sc; v1 = v1 * sc; u32x4 w; w.x = cvt_pk_bf16(v0[0], v0[1]); w.y = cvt_pk_bf16(v0[2], v0[3]); w.z = cvt_pk_bf16(v1[0], v1[1]); w.w = cvt_pk_bf16(v1[2], v1[3]);
                    *(u32x4*)(rowp + bj * HALF) = w; } }
    }
};
template <class E_> constexpr auto midk_of(int) -> decltype(E_::MIDK_T) { return E_::MIDK_T; }
template <class E_> constexpr int midk_of(long) { return -1; }
template <class Epi, class Sched, bool ALIGN_EPI = false, bool SP2 = false, bool GATHER = false, bool F8 = false>
__device__ __forceinline__ void gemm_phase(PG8_LAS unsigned char* lds, const Gemm g, const Sched& S, const Epi& E) {
    static_assert(!GATHER || SP2, "GATHER is wired into the SP2 loop only");
    const int tid = threadIdx.x, wid = __builtin_amdgcn_readfirstlane(tid >> 6), lane = tid & 63, wr = wid >> 2, wc = wid & 3, fr = lane & 15, fq = lane >> 4;
    const int K = g.K, KB = F8 ? g.K : g.K * 2, nt = KB / (BK * 2);
    unsigned voffA[2], voffB[2];
#pragma unroll
    for (int i = 0; i < 2; ++i) { int R, C; stage_rc(tid * 16 + i * 8192, R, C); const int Rb = Epi::PERM ? ((R & ~31) + perm32(R & 31)) : R;
        voffA[i] = (unsigned)(R * KB + C * 2); voffB[i] = (unsigned)(Rb * KB + C * 2); }
    unsigned goffC[2][2] = {{0u, 0u}, {0u, 0u}}, goffN[2][2] = {{0u, 0u}, {0u, 0u}};
#define PG8_GOFF(dst, u_) do { _Pragma("unroll") for (int h_ = 0; h_ < 2; ++h_) _Pragma("unroll") for (int i_ = 0; i_ < 2; ++i_) \
        { int R_, C_; stage_rc(tid * 16 + i_ * 8192, R_, C_); dst[h_][i_] = (unsigned)(g.tok[(u_).pm * BM + h_ * HALF + R_] * KB + C_ * 2); } asm volatile("" : "+v"(dst[0][0]), "+v"(dst[0][1]), "+v"(dst[1][0]), "+v"(dst[1][1])); } while (0)
    const size_t kstep = (size_t)(BK * 2);
    const size_t hstep = (size_t)HALF * KB;
    const size_t tstep = 2 * hstep;
    const unsigned ldsw = (unsigned)wid * 1024u;
    const int aoffk[2] = {lds_byte(wr * 64 + fr, F8 ? 16 * fq : fq * 8), lds_byte(wr * 64 + fr, F8 ? 16 * fq + 8 : fq * 8 + 32)};
    const int boffk[2] = {lds_byte(wc * 32 + fr, F8 ? 16 * fq : fq * 8), lds_byte(wc * 32 + fr, F8 ? 16 * fq + 8 : fq * 8 + 32)};
#define PG8_SA(b, h) (((b) * 2 + (h)) * HTB)
#define PG8_SB(b, h) ((4 + (b) * 2 + (h)) * HTB)
#define PG8_STAGE(bufoff, gbase, voff) do { _Pragma("unroll") for (int _i = 0; _i < 2; ++_i) \
        __builtin_amdgcn_global_load_lds((const unsigned*)((const char*)(gbase) + (voff)[_i]), (PG8_LAS unsigned*)(lds + (bufoff) + ldsw + _i * 8192), 16, 0, 0); } while (0)
#define PG8_STAGE_A(b, h, ptr, useN) do { if constexpr (GATHER) { if (useN) PG8_STAGE(PG8_SA(b, h), ptr, goffN[h]); else PG8_STAGE(PG8_SA(b, h), ptr, goffC[h]); } \
        else PG8_STAGE(PG8_SA(b, h), (ptr) + ((h) ? hstep : 0), voffA); } while (0)
#define PG8_LDA(dst, b, h) do { if constexpr (!F8) _Pragma("unroll") for (int m = 0; m < 4; ++m) _Pragma("unroll") for (int k = 0; k < 2; ++k) dst[m][k] = *(const PG8_LAS bf16x8*)(lds + PG8_SA(b, h) + aoffk[k] + m * 2048); if constexpr (F8) { _Pragma("unroll") for (int m = 0; m < 4; ++m) dst##8[m] = __builtin_bit_cast(i32x8_, __builtin_shufflevector(*(const PG8_LAS bf16x8*)(lds + PG8_SA(b, h) + aoffk[0] + m * 2048), *(const PG8_LAS bf16x8*)(lds + PG8_SA(b, h) + aoffk[0] + m * 2048 + 16), 0, 1, 2, 3, 4, 5, 6, 7, 8, 9, 10, 11, 12, 13, 14, 15)); } } while (0)
#define PG8_LDB(dst, b, h) do { if constexpr (!F8) _Pragma("unroll") for (int n = 0; n < 2; ++n) _Pragma("unroll") for (int k = 0; k < 2; ++k) dst[n][k] = *(const PG8_LAS bf16x8*)(lds + PG8_SB(b, h) + boffk[k] + n * 2048); if constexpr (F8) { _Pragma("unroll") for (int n = 0; n < 2; ++n) dst##8[n] = __builtin_bit_cast(i32x8_, __builtin_shufflevector(*(const PG8_LAS bf16x8*)(lds + PG8_SB(b, h) + boffk[0] + n * 2048), *(const PG8_LAS bf16x8*)(lds + PG8_SB(b, h) + boffk[0] + n * 2048 + 16), 0, 1, 2, 3, 4, 5, 6, 7, 8, 9, 10, 11, 12, 13, 14, 15)); } } while (0)
#define PG8_MMA(ai, bj, At, Bt) do { __builtin_amdgcn_s_setprio(1); _Pragma("unroll") for (int m = 0; m < 4; ++m) _Pragma("unroll") for (int n = 0; n < 2; ++n) { \
        if constexpr (F8) asm volatile("v_mfma_scale_f32_16x16x128_f8f6f4 %0, %1, %2, %0, %3, %3 op_sel_hi:[0,0,0]" : "+v"(acc[ai][bj][m][n]) : "v"(Bt##8[n]), "v"(At##8[m]), "v"(0x7f7f7f7f));   \
        else { _Pragma("unroll") for (int k = 0; k < 2; ++k) acc[ai][bj][m][n] = __builtin_amdgcn_mfma_f32_16x16x32_bf16(Bt[n][k], At[m][k], acc[ai][bj][m][n], 0, 0, 0); } } \
        __builtin_amdgcn_s_setprio(0); } while (0)
#define PG8_WAIT_V(n) asm volatile("s_waitcnt vmcnt(" #n ")" ::: "memory")
#define PG8_WAIT_L(n) asm volatile("s_waitcnt lgkmcnt(" #n ")" ::: "memory")
#define PG8_BAR __builtin_amdgcn_s_barrier()
#define PG8_SCHED __builtin_amdgcn_sched_barrier(0)
    Unit cur, nxt; int ui = 0;
    if (!S.next(0, cur)) return;
    f32x4 acc[2][2][4][2];
#pragma unroll
    for (int a = 0; a < 2; ++a)
#pragma unroll
        for (int b = 0; b < 2; ++b)
#pragma unroll
            for (int m = 0; m < 4; ++m)
#pragma unroll
                for (int n = 0; n < 2; ++n) acc[a][b][m][n] = (f32x4){0.f, 0.f, 0.f, 0.f};
    bf16x8 At[4][2], B0[2][2], B1[2][2];
    i32x8_ At8[4], B08[2], B18[2];
    const char* cA = (const char*)g.A + (GATHER ? (size_t)0 : (size_t)cur.pm * tstep); const char* cB = (const char*)g.Bt + (size_t)cur.pn * tstep;
    if constexpr (GATHER) { PG8_GOFF(goffC, cur); Unit n1_; if (S.next(1, n1_)) PG8_GOFF(goffN, n1_); }
    S.a_ready(cur);
    if constexpr (SP2) {
        PG8_STAGE(PG8_SB(0, 0), cB, voffB); PG8_STAGE(PG8_SB(0, 1), cB + hstep, voffB); PG8_STAGE_A(0, 0, cA, false); PG8_STAGE_A(0, 1, cA, false);
        if (wr == 1) PG8_BAR;
        PG8_WAIT_V(2); PG8_BAR;
        PG8_STAGE(PG8_SB(1, 0), cB + kstep, voffB); PG8_STAGE_A(1, 0, cA + kstep, false); PG8_STAGE(PG8_SB(1, 1), cB + hstep + kstep, voffB);
        PG8_WAIT_V(6); PG8_BAR;
    } else {
        PG8_STAGE(PG8_SB(0, 0), cB, voffB); PG8_STAGE(PG8_SA(0, 0), cA, voffA); PG8_STAGE(PG8_SB(0, 1), cB + hstep, voffB); PG8_STAGE(PG8_SA(0, 1), cA + hstep, voffA);
        if (wr == 1) PG8_BAR;
        PG8_WAIT_V(4); PG8_BAR;
        PG8_STAGE(PG8_SB(1, 0), cB + kstep, voffB); PG8_STAGE(PG8_SA(1, 0), cA + kstep, voffA); PG8_STAGE(PG8_SB(1, 1), cB + hstep + kstep, voffB);
        PG8_WAIT_V(6); PG8_BAR;
    }
    for (;;) {
        const bool has_next = S.next(ui + 1, nxt);
        const char* nA = (has_next && !GATHER) ? (const char*)g.A + (size_t)nxt.pm * tstep : cA; const char* nB = has_next ? (const char*)g.Bt + (size_t)nxt.pn * tstep : cB;
#define PG8_KBODY \
            const bool last = (t == nt - 2); \
            const char* a1 = cA + (size_t)(t + 1) * kstep; \
            const char* a2 = last ? nA : cA + (size_t)(t + 2) * kstep; const char* b2 = last ? nB : cB + (size_t)(t + 2) * kstep; \
            const char* a3 = a2 + kstep; const char* b3 = b2 + kstep; \
            if (last && has_next) S.a_ready(nxt); \
            const bool useN = last && has_next; \
            if constexpr (SP2) { \
            PG8_LDB(B0, 0, 0); PG8_LDB(B1, 0, 1); PG8_SCHED; PG8_LDA(At, 0, 0); PG8_STAGE_A(1, 1, a1, false); \
            PG8_WAIT_V(8); PG8_WAIT_L(0); PG8_BAR; PG8_MMA(0, 0, At, B0); PG8_MMA(0, 1, At, B1); PG8_BAR; PG8_SCHED; \
            PG8_LDA(At, 0, 1); PG8_STAGE(PG8_SB(0, 0), b2, voffB); PG8_STAGE(PG8_SB(0, 1), b2 + hstep, voffB); PG8_STAGE_A(0, 0, a2, useN); \
            PG8_WAIT_V(8); PG8_WAIT_L(0); PG8_BAR; PG8_MMA(1, 0, At, B0); PG8_MMA(1, 1, At, B1); PG8_BAR; PG8_SCHED; \
            PG8_LDB(B0, 1, 0); PG8_LDB(B1, 1, 1); PG8_SCHED; PG8_LDA(At, 1, 0); PG8_STAGE_A(0, 1, a2, useN); \
            PG8_WAIT_V(8); PG8_WAIT_L(0); PG8_BAR; PG8_MMA(0, 0, At, B0); PG8_MMA(0, 1, At, B1); PG8_BAR; PG8_SCHED; \
            PG8_LDA(At, 1, 1); PG8_STAGE(PG8_SB(1, 0), b3, voffB); PG8_STAGE(PG8_SB(1, 1), b3 + hstep, voffB); PG8_STAGE_A(1, 0, a3, useN); \
            PG8_WAIT_V(8); PG8_WAIT_L(0); PG8_BAR; PG8_MMA(1, 0, At, B0); PG8_MMA(1, 1, At, B1); PG8_BAR; PG8_SCHED; \
            } else { \
            PG8_LDB(B0, 0, 0); PG8_SCHED; PG8_LDA(At, 0, 0); PG8_STAGE(PG8_SA(1, 1), a1 + hstep, voffA); \
            PG8_WAIT_L(8); PG8_BAR; PG8_WAIT_L(0); PG8_MMA(0, 0, At, B0); PG8_BAR; PG8_SCHED; \
            PG8_LDB(B1, 0, 1); PG8_STAGE(PG8_SB(0, 0), b2, voffB); \
            PG8_BAR; PG8_WAIT_L(0); PG8_MMA(0, 1, At, B1); PG8_BAR; \
            PG8_LDA(At, 0, 1); PG8_STAGE(PG8_SA(0, 0), a2, voffA); \
            PG8_BAR; PG8_WAIT_L(0); PG8_MMA(1, 0, At, B0); PG8_BAR; PG8_SCHED; \
            PG8_STAGE(PG8_SB(0, 1), b2 + hstep, voffB); \
            PG8_WAIT_V(6); PG8_BAR; PG8_MMA(1, 1, At, B1); PG8_BAR; \
            PG8_LDB(B0, 1, 0); PG8_SCHED; PG8_LDA(At, 1, 0); PG8_STAGE(PG8_SA(0, 1), a2 + hstep, voffA); \
            PG8_WAIT_L(8); PG8_BAR; PG8_WAIT_L(0); PG8_MMA(0, 0, At, B0); PG8_BAR; PG8_SCHED; \
            PG8_LDB(B1, 1, 1); PG8_STAGE(PG8_SB(1, 0), b3, voffB); \
            PG8_BAR; PG8_WAIT_L(0); PG8_MMA(0, 1, At, B1); PG8_BAR; \
            PG8_LDA(At, 1, 1); PG8_STAGE(PG8_SA(1, 0), a3, voffA); \
            PG8_BAR; PG8_WAIT_L(0); PG8_MMA(1, 0, At, B0); PG8_BAR; PG8_SCHED; \
            PG8_STAGE(PG8_SB(1, 1), b3 + hstep, voffB); \
            PG8_WAIT_V(6); PG8_BAR; PG8_MMA(1, 1, At, B1); PG8_BAR; \
            } \

        { int t = 0;
          if constexpr (midk_of<Epi>(0) >= 0) { for (; t < midk_of<Epi>(0); t += 2) { PG8_KBODY } E.mid(acc, cur, wr, wc, fr, fq); }
          _Pragma("unroll 1") for (; t < nt; t += 2) { PG8_KBODY } }
#undef PG8_KBODY
        if constexpr (ALIGN_EPI) { if (wr == 0) PG8_BAR; }
        if constexpr (F8) asm volatile("s_nop 15\n\ts_nop 15" ::: "memory");
        if constexpr (!Epi::AFTER_DRAIN) { E(acc, cur, wr, wc, fr, fq); S.done(cur); }
        if (!has_next) break;
#pragma unroll
        for (int a = 0; a < 2; ++a)
#pragma unroll
            for (int b = 0; b < 2; ++b)
#pragma unroll
                for (int m = 0; m < 4; ++m)
#pragma unroll
                    for (int n = 0; n < 2; ++n) acc[a][b][m][n] = (f32x4){0.f, 0.f, 0.f, 0.f};
        cur = nxt; cA = nA; cB = nB; ++ui;
        if constexpr (GATHER) { _Pragma("unroll") for (int h_ = 0; h_ < 2; ++h_) _Pragma("unroll") for (int i_ = 0; i_ < 2; ++i_) goffC[h_][i_] = goffN[h_][i_];
            Unit n2_; if (S.next(ui + 1, n2_)) PG8_GOFF(goffN, n2_); }
        if constexpr (ALIGN_EPI) { if (wr == 1) PG8_BAR; }
    }
    PG8_WAIT_V(0);
    if constexpr (!ALIGN_EPI) { if (wr == 0) PG8_BAR; }
    PG8_BAR;
    if constexpr (Epi::AFTER_DRAIN) { E.fused(acc, cur, wr, wc, fr, fq, lds, wid, lane); S.done(cur); }
#undef PG8_SA
#undef PG8_SB
#undef PG8_STAGE
#undef PG8_STAGE_A
#undef PG8_GOFF
#undef PG8_LDA
#undef PG8_LDB
#undef PG8_MMA
#undef PG8_WAIT_V
#undef PG8_WAIT_L
#undef PG8_BAR
#undef PG8_SCHED
}
}

#define GAS __attribute__((address_space(1)))
#define LAS __attribute__((address_space(3)))
typedef unsigned short bf16;
typedef unsigned v4u __attribute__((ext_vector_type(4)));
typedef unsigned v2u __attribute__((ext_vector_type(2)));
typedef float f32x4 __attribute__((ext_vector_type(4)));
typedef GAS unsigned gu32;
#define RLX_AGENT __ATOMIC_RELAXED, __HIP_MEMORY_SCOPE_AGENT
#define LDS_WAIT() asm volatile("s_waitcnt lgkmcnt(0)" ::: "memory")
#define VM_WAIT() asm volatile("s_waitcnt vmcnt(0)" ::: "memory")
__device__ __forceinline__ unsigned f2bf(float f) { unsigned u = __builtin_bit_cast(unsigned, f); return (u + 0x7fffu + ((u >> 16) & 1u)) >> 16; }
__device__ __forceinline__ unsigned pk2(float lo, float hi) { return f2bf(lo) | (f2bf(hi) << 16); }
__device__ __forceinline__ float bflo(unsigned w) { return __builtin_bit_cast(float, w << 16); }
__device__ __forceinline__ float bfhi(unsigned w) { return __builtin_bit_cast(float, w & 0xffff0000u); }
__device__ __forceinline__ float bf2f(bf16 b) { return __builtin_bit_cast(float, (unsigned)b << 16); }
__device__ __forceinline__ float sigmoidf_(float x) { return 1.f / (1.f + __expf(-x)); }
__device__ __forceinline__ float siluf_(float x) { return x / (1.f + __expf(-x)); }
__device__ __forceinline__ float wave_sum(float v) {
#pragma unroll
    for (int o = 1; o < 64; o <<= 1) v += __shfl_xor(v, o);
    return v;
}
#define XB_TMO      128
#define XB_XCNT(j)  (256  + 64 * (j))
#define XB_XSUB(j)  (1280 + 64 * (j))
#define XB_XGEN(j)  (2304 + 64 * (j))
#define XB_TOP      3328
#define XB_TOPGEN   3392
#define XCD_BAR_WORDS 3456
#define XB_SPIN_CAP (1u << 18)

__device__ __forceinline__ unsigned xb_ld(unsigned* p)              { return __hip_atomic_load(p, __ATOMIC_RELAXED, __HIP_MEMORY_SCOPE_AGENT); }
__device__ __forceinline__ unsigned xb_add(unsigned* p, unsigned v) { return __hip_atomic_fetch_add(p, v, __ATOMIC_RELAXED, __HIP_MEMORY_SCOPE_AGENT); }
__device__ __forceinline__ unsigned xb_xcc_id() { return (unsigned)__builtin_amdgcn_s_getreg((3 << 11) | 20) & 0xFu; }
#define XB_SPIN(cond, bar) do { unsigned _sp = 0; while (cond) { __builtin_amdgcn_s_sleep(1); \
    if ((++_sp & 255u) == 0u) { if (xb_ld(&(bar)[XB_TMO])) break; if (_sp > XB_SPIN_CAP) { atomicAdd(&(bar)[XB_TMO], 1u); break; } } } } while (0)

struct XcdBarrier {
    unsigned* bar; unsigned x;
    volatile LAS unsigned* st;
};

__device__ __forceinline__ XcdBarrier xcd_barrier_post(unsigned* bar, volatile LAS unsigned* st) {
    XcdBarrier b; b.bar = bar; b.x = xb_xcc_id(); b.st = st;
    if (threadIdx.x == 0) (void)xb_add(&bar[XB_XCNT(b.x)], 1u);
    return b;
}
__device__ __forceinline__ void xcd_barrier_complete(unsigned* bar, unsigned x, unsigned& nloc, unsigned& nx) {
    const unsigned G = gridDim.x * gridDim.y * gridDim.z;
    unsigned sum, cnt, mine, sp = 0u;
    for (;;) {
        sum = 0u; cnt = 0u; mine = 0u;
#pragma unroll
        for (unsigned j = 0; j < 16; ++j) { const unsigned c = xb_ld(&bar[XB_XCNT(j)]); sum += c; cnt += (c > 0u) ? 1u : 0u; mine = (j == x) ? c : mine; }
        if (sum == G) break;
        __builtin_amdgcn_s_sleep(1);
        if ((++sp & 255u) == 0u) { if (xb_ld(&bar[XB_TMO])) break; if (sp > XB_SPIN_CAP) { atomicAdd(&bar[XB_TMO], 1u); break; } }
    }
    nloc = mine > 0u ? mine : 1u; nx = cnt > 0u ? cnt : 1u;
}

__device__ __forceinline__ void xcd_barrier(const XcdBarrier& b) {
    asm volatile("s_waitcnt vmcnt(0)" ::: "memory");
    __syncthreads();
    if (threadIdx.x == 0) {
        unsigned* bar = b.bar;
        __builtin_amdgcn_s_waitcnt(0);
        unsigned nloc = b.st[0], nx = b.st[1];
        if (nloc == 0u) { xcd_barrier_complete(bar, b.x, nloc, nx); b.st[0] = nloc; b.st[1] = nx; }
        const unsigned old = xb_add(&bar[XB_XSUB(b.x)], 1u);
        const unsigned gen = old / nloc;
        if (old + 1u == (gen + 1u) * nloc) {
            __builtin_amdgcn_fence(__ATOMIC_RELEASE, "agent");
            asm volatile("s_waitcnt vmcnt(0)" ::: "memory");
            const unsigned og = xb_add(&bar[XB_TOP], 1u);
            const unsigned tg = og / nx;
            if (og + 1u == (tg + 1u) * nx) xb_add(&bar[XB_TOPGEN], 1u);
            else XB_SPIN(xb_ld(&bar[XB_TOPGEN]) == tg, bar);
            __builtin_amdgcn_fence(__ATOMIC_ACQUIRE, "agent");
            xb_add(&bar[XB_XGEN(b.x)], 1u);
            asm volatile("s_waitcnt vmcnt(0)" ::: "memory");
        } else {
            XB_SPIN(xb_ld(&bar[XB_XGEN(b.x)]) == gen, bar);
            __builtin_amdgcn_fence(__ATOMIC_ACQUIRE, "agent");
            asm volatile("s_waitcnt vmcnt(0)" ::: "memory");
        }
    }
    __syncthreads();
}

constexpr int SEQ = 16384, DM = 1024, NPROJ = 5632, INCOLS = 5640, NMEM = 256, NEXP = 32;
constexpr int NWAVES = 8, NTHR = 512;
constexpr float EPS = 1e-6f;
constexpr int PC_QA = 0, PC_KA = 512, PC_VA = 1024, PC_QB = 1536, PC_ZB = 3072, PC_GA = 3584, PC_GB = 4608;
constexpr size_t MiB = 1u << 20;
constexpr size_t WS_CTL = 0, CTL_ZERO_BYTES = 1 * MiB;
constexpr size_t WS_WT_IN = 2 * MiB, WS_WT_UPA = 14 * MiB, WS_WT_UPB = 15 * MiB, WS_WT_OUT = 16 * MiB, WS_WT_QX = 18 * MiB, WS_WT_KV = 20 * MiB, WS_WT_OX = 24 * MiB;
constexpr size_t WS_W1T = 32 * MiB, WS_W2T = 160 * MiB, WS_H = 224 * MiB, WS_PROJ = 256 * MiB;
constexpr size_t WS_OA = 432 * MiB, WS_OB = 448 * MiB, WS_MRG = 464 * MiB, WS_X1 = 496 * MiB, WS_X2 = 560 * MiB, WS_QX = 624 * MiB, WS_OX = 656 * MiB;
constexpr size_t WS_KVX = 688 * MiB, WS_MEMN = 689 * MiB, WS_GG = 690 * MiB, WS_GBETA = 690 * MiB + 512 * 1024, WS_GQKV = 692 * MiB, WS_GO = 780 * MiB;
constexpr size_t WS_TOPE = 772 * MiB, WS_TOPW = 772 * MiB + 256 * 1024, WS_SPOS = 772 * MiB + 512 * 1024, WS_SLOTW = 773 * MiB;
constexpr size_t WS_VIMG = 800 * MiB;
constexpr size_t WS_H8 = 808 * MiB, WS_WT_IN8 = 824 * MiB;
constexpr size_t WS_XS = 776 * MiB, WS_ACT = 256 * MiB, WS_YS = 400 * MiB, WS_END = 1024 * MiB;
constexpr int CW_BAR = 4096, CW_CNT = 16384;
constexpr int RING_BYTES = 131072, EXTRA_OFF = 131072, MISC_OFF = 139264, LDS_BYTES = 147456;
constexpr int NPH = 15;

struct Args { const float* in[30]; float* out; unsigned char* ws; int ph_lo, ph_hi; };

#define WSP(T, off) ((T*)(a.ws + (off)))

#ifndef MOE_F8
#define MOE_F8 1
#endif
#ifndef FP8_X
#define FP8_X 1
#endif
#ifndef PV_F8
#define PV_F8 1
#endif
#ifndef GATE_F8
#define GATE_F8 1
#endif
#ifndef FP8_IN
#define FP8_IN 0
#endif
constexpr float W8_SCALE = 32.f;
__device__ __forceinline__ unsigned pk4_fp8(float a, float b, float c, float d) { int w = 0; w = __builtin_amdgcn_cvt_pk_fp8_f32(a, b, w, false); w = __builtin_amdgcn_cvt_pk_fp8_f32(c, d, w, true); return (unsigned)w; }
template <bool F8 = false>
__device__ __forceinline__ void tr_item(const float* __restrict__ W, int ldw, int col0, bf16* WT, int ldk, size_t drow0, int dk0, int k0, LAS float* scr, int lane, const float* kscale = nullptr) {
    const int c4 = (lane & 15) * 4, r4 = lane >> 4;
    f32x4 v[16];
#pragma unroll
    for (int i = 0; i < 16; ++i) v[i] = __builtin_nontemporal_load((const f32x4*)(W + (size_t)(k0 + r4 + 4 * i) * ldw + col0 + c4));
    if (kscale) {
#pragma unroll
        for (int i = 0; i < 16; ++i) v[i] = v[i] * kscale[k0 + r4 + 4 * i]; }
#pragma unroll
    for (int i = 0; i < 16; ++i) { LAS float* s = scr + (r4 + 4 * i) * 65 + c4; s[0] = v[i].x; s[1] = v[i].y; s[2] = v[i].z; s[3] = v[i].w; }
    LDS_WAIT(); asm volatile("" ::: "memory");
    const int c = lane & 7;
#pragma unroll
    for (int j = 0; j < 8; ++j) { const int n = (lane >> 3) + 8 * j; const LAS float* s = scr + (8 * c) * 65 + n;
        if (F8) { v2u o; o.x = pk4_fp8(s[0] * W8_SCALE, s[65] * W8_SCALE, s[130] * W8_SCALE, s[195] * W8_SCALE); o.y = pk4_fp8(s[260] * W8_SCALE, s[325] * W8_SCALE, s[390] * W8_SCALE, s[455] * W8_SCALE);
            *(v2u*)((unsigned char*)WT + (drow0 + n) * (size_t)ldk + dk0 + k0 + 8 * c) = o; }
        else { v4u o; o.x = pk2(s[0], s[65]); o.y = pk2(s[130], s[195]); o.z = pk2(s[260], s[325]); o.w = pk2(s[390], s[455]);
            *(v4u*)(WT + (drow0 + n) * (size_t)ldk + dk0 + k0 + 8 * c) = o; } }
    LDS_WAIT(); asm volatile("" ::: "memory");
}
__device__ __forceinline__ float rms_row_load(const float* xrow, const float* g, int lane, f32x4 (&v)[4]) {
    const f32x4* xr = (const f32x4*)xrow + lane; float s = 0.f;
#pragma unroll
    for (int j = 0; j < 4; ++j) { v[j] = xr[64 * j]; s += (v[j].x * v[j].x + v[j].y * v[j].y) + (v[j].z * v[j].z + v[j].w * v[j].w); }
    const float rstd = rsqrtf(wave_sum(s) * (1.f / DM) + EPS);
#pragma unroll
    for (int j = 0; j < 4; ++j) { const f32x4 gv = ((const f32x4*)g)[lane + 64 * j]; v[j] = v[j] * rstd * gv; }
    return rstd;
}
__device__ __forceinline__ float rms_row_load_bf16(const bf16* xrow, const float* g, int lane, f32x4 (&v)[4]) {
    const v2u* xr = (const v2u*)xrow + lane; float s = 0.f;
#pragma unroll
    for (int j = 0; j < 4; ++j) { const v2u r = xr[64 * j]; v[j] = (f32x4){bflo(r.x), bfhi(r.x), bflo(r.y), bfhi(r.y)}; s += (v[j].x * v[j].x + v[j].y * v[j].y) + (v[j].z * v[j].z + v[j].w * v[j].w); }
    const float rstd = rsqrtf(wave_sum(s) * (1.f / DM) + EPS);
#pragma unroll
    for (int j = 0; j < 4; ++j) { const f32x4 gv = ((const f32x4*)g)[lane + 64 * j]; v[j] = v[j] * rstd * gv; }
    return rstd;
}
__device__ __forceinline__ void row_store_bf16(bf16* orow, int lane, const f32x4 (&v)[4]) {
    unsigned long long* o8 = (unsigned long long*)orow + lane;
#pragma unroll
    for (int j = 0; j < 4; ++j) o8[64 * j] = (unsigned long long)pk2(v[j].x, v[j].y) | ((unsigned long long)pk2(v[j].z, v[j].w) << 32);
}
__device__ __forceinline__ void rms_rows_bf16(const float* X, const float* g, bf16* O, int nrows, int gw, int NGW, int lane) {
    for (int t = gw; t < nrows; t += NGW) { f32x4 v[4]; rms_row_load(X + (size_t)t * DM, g, lane, v); row_store_bf16(O + (size_t)t * DM, lane, v); }
}
constexpr int ITEMS_MOE = 32 * 512 + 32 * 256;
__device__ __forceinline__ void prep_items(const Args& a, LAS float* scr, int lane, int first, int stride, int limit = 0x7fffffff) {
    constexpr int I7 = 32 * 512, I8 = 32 * 256, I0 = 16 * 88, I1 = 128, I2 = 128, I3 = 256, I4 = 256, I5 = 512, I6 = 256;
    constexpr int NITEMS = I7 + I8 + I0 + I1 + I2 + I3 + I4 + I5 + I6;
    const int end = limit < NITEMS ? limit : NITEMS;
    for (int it = first; it < end; it += stride) { int r = it;
        if (r < I7) { const int e = r >> 9, q = r & 511, kb = q >> 5, n0 = (q & 31) * 64, j = n0 >> 8, rr = n0 & 255, col0 = rr < 128 ? 128 * j + rr : 1024 + 128 * j + rr - 128;
            tr_item<MOE_F8 != 0>(a.in[25] + (size_t)e * 1024 * 2048, 2048, col0, WSP(bf16, WS_W1T), 1024, (size_t)e * 2048 + n0, 0, kb * 64, scr, lane, a.in[22]); continue; } r -= I7;
        if (r < I8) { const int e = r >> 8, q = r & 255, kb = q >> 4, n0 = (q & 15) * 64;
            tr_item<MOE_F8 != 0>(a.in[27] + (size_t)e * 1024 * 1024, 1024, n0, WSP(bf16, WS_W2T), 1024, (size_t)e * 1024 + n0, 0, kb * 64, scr, lane); continue; } r -= I8;
        if (r < I0) { const int kb = r / 88, n0 = (r % 88) * 64, col0 = n0 < 3584 ? n0 : n0 + 8;
            if (GATE_F8 && n0 >= 3072) tr_item<true>(a.in[3], INCOLS, col0, WSP(bf16, WS_WT_IN8), 1024, n0 - 3072, 0, kb * 64, scr, lane);
            else tr_item<FP8_IN != 0>(a.in[3], INCOLS, col0, WSP(bf16, WS_WT_IN), 1024, n0, 0, kb * 64, scr, lane);
            continue; } r -= I0;
        if (r < I1) { tr_item(a.in[14], 1024, (r & 15) * 64, WSP(bf16, WS_WT_UPA), 512, (r & 15) * 64, 0, (r >> 4) * 64, scr, lane); continue; } r -= I1;
        if (r < I2) { tr_item(a.in[15], 1024, (r & 15) * 64, WSP(bf16, WS_WT_UPB), 512, (r & 15) * 64, 0, (r >> 4) * 64, scr, lane); continue; } r -= I2;
        if (r < I3) { tr_item(a.in[16], 1024, (r & 15) * 64, WSP(bf16, WS_WT_OUT), 1024, (r & 15) * 64, 0, (r >> 4) * 64, scr, lane); continue; } r -= I3;
        if (r < I4) { tr_item<FP8_X != 0>(a.in[19], 1024, (r & 15) * 64, WSP(bf16, WS_WT_QX), 1024, (r & 15) * 64, 0, (r >> 4) * 64, scr, lane, a.in[17]); continue; } r -= I4;
        if (r < I5) { tr_item(a.in[20], 2048, (r & 31) * 64, WSP(bf16, WS_WT_KV), 1024, (r & 31) * 64, 0, (r >> 5) * 64, scr, lane); continue; } r -= I5;
        tr_item<FP8_X != 0>(a.in[21], 1024, (r & 15) * 64, WSP(bf16, WS_WT_OX), 1024, (r & 15) * 64, 0, (r >> 4) * 64, scr, lane);
    }
}

struct MoeIt { const float* src; size_t ldw; unsigned char* dst; const float* ks; int k0; };
__device__ __forceinline__ MoeIt moe_item(const Args& a, int r, int lane) {
    constexpr int I7 = 32 * 512;
    const int c4 = (lane & 15) * 4, r4 = lane >> 4; MoeIt m;
    if (r < I7) { const int e = r >> 9, q = r & 511, kb = q >> 5, n0 = (q & 31) * 64, j = n0 >> 8, rr = n0 & 255, col0 = rr < 128 ? 128 * j + rr : 1024 + 128 * j + rr - 128;
        m.k0 = kb * 64; m.ldw = 2048; m.src = a.in[25] + (size_t)e * 1024 * 2048 + (size_t)(m.k0 + r4) * 2048 + col0 + c4; m.ks = a.in[22];
        m.dst = (unsigned char*)WSP(bf16, WS_W1T) + ((size_t)e * 2048 + n0) * (MOE_F8 ? 1024 : 2048) + (size_t)m.k0 * (MOE_F8 ? 1 : 2); }
    else { r -= I7; const int e = r >> 8, q = r & 255, kb = q >> 4, n0 = (q & 15) * 64;
        m.k0 = kb * 64; m.ldw = 1024; m.src = a.in[27] + (size_t)e * 1024 * 1024 + (size_t)(m.k0 + r4) * 1024 + n0 + c4; m.ks = nullptr;
        m.dst = (unsigned char*)WSP(bf16, WS_W2T) + ((size_t)e * 1024 + n0) * (MOE_F8 ? 1024 : 2048) + (size_t)m.k0 * (MOE_F8 ? 1 : 2); }
    return m;
}
#define MOE_LOAD(V, M) do { _Pragma("unroll") for (int i = 0; i < 16; ++i) V[i] = __builtin_nontemporal_load((const f32x4*)((M).src + (size_t)(4 * i) * (M).ldw)); } while (0)
__device__ __forceinline__ void moe_process(f32x4 (&v)[16], const MoeIt& m, LAS float* scr, int lane) {
    const int c4 = (lane & 15) * 4, r4 = lane >> 4;
    if (m.ks) {
#pragma unroll
        for (int i = 0; i < 16; ++i) v[i] = v[i] * m.ks[m.k0 + r4 + 4 * i]; }
#pragma unroll
    for (int i = 0; i < 16; ++i) { LAS float* s = scr + (r4 + 4 * i) * 65 + c4; s[0] = v[i].x; s[1] = v[i].y; s[2] = v[i].z; s[3] = v[i].w; }
    LDS_WAIT(); asm volatile("" ::: "memory");
    const int c = lane & 7;
#pragma unroll
    for (int j = 0; j < 8; ++j) { const int n = (lane >> 3) + 8 * j; const LAS float* s = scr + (8 * c) * 65 + n;
        if (MOE_F8) { v2u o; o.x = pk4_fp8(s[0] * W8_SCALE, s[65] * W8_SCALE, s[130] * W8_SCALE, s[195] * W8_SCALE); o.y = pk4_fp8(s[260] * W8_SCALE, s[325] * W8_SCALE, s[390] * W8_SCALE, s[455] * W8_SCALE);
            *(v2u*)(m.dst + (size_t)n * 1024 + 8 * c) = o; }
        else { v4u o; o.x = pk2(s[0], s[65]); o.y = pk2(s[130], s[195]); o.z = pk2(s[260], s[325]); o.w = pk2(s[390], s[455]);
            *(v4u*)(m.dst + (size_t)n * 2048 + 16 * c) = o; } }
    LDS_WAIT(); asm volatile("" ::: "memory");
}
__device__ __forceinline__ void prep_moe_pf(const Args& a, LAS float* scr, int lane, int first, int stride) {
    f32x4 va[16], vb[16];
    int it = first;
    if (it >= ITEMS_MOE) return;
    MoeIt ma = moe_item(a, it, lane), mb = ma;
    MOE_LOAD(va, ma);
    while (true) {
        int nx = it + stride;
        if (nx < ITEMS_MOE) { mb = moe_item(a, nx, lane); MOE_LOAD(vb, mb); }
        moe_process(va, ma, scr, lane);
        it = nx; if (it >= ITEMS_MOE) break;
        nx = it + stride;
        if (nx < ITEMS_MOE) { ma = moe_item(a, nx, lane); MOE_LOAD(va, ma); }
        moe_process(vb, mb, scr, lane);
        it = nx; if (it >= ITEMS_MOE) break;
    }
}
__device__ __forceinline__ void phase_prep(const Args& a, LAS unsigned char* lds, int tid, int lane, int wave, int G, int bid) {
    LAS float* scr = (LAS float*)(lds + wave * 16640);
    LAS float* wab = (LAS float*)(lds + 81920);
    const int gw = bid * NWAVES + wave, NGW = G * NWAVES;
    for (int i = tid; i < 8192; i += NTHR) { const int k = i >> 3, c = i & 7; wab[c * 1024 + k] = a.in[3][(size_t)k * INCOLS + 3584 + c]; }
    __syncthreads();
    bf16* H = WSP(bf16, WS_H); float* GG = WSP(float, WS_GG); float* GB = WSP(float, WS_GBETA);
    for (int t = gw; t < SEQ; t += NGW) {
        f32x4 v[4]; rms_row_load(a.in[0] + (size_t)t * DM, a.in[2], lane, v); if (FP8_IN) {
#pragma unroll
            for (int j = 0; j < 4; ++j) ((unsigned*)((unsigned char*)H + (size_t)t * DM))[lane + 64 * j] = pk4_fp8(v[j].x, v[j].y, v[j].z, v[j].w); }
        else row_store_bf16(H + (size_t)t * DM, lane, v);
        if (GATE_F8) {
#pragma unroll
            for (int j = 0; j < 4; ++j) ((unsigned*)(a.ws + WS_H8 + (size_t)t * DM))[lane + 64 * j] = pk4_fp8(v[j].x, v[j].y, v[j].z, v[j].w); }
        float mine = 0.f;
#pragma unroll
        for (int c = 0; c < 8; ++c) { float p = 0.f;
#pragma unroll
            for (int j = 0; j < 4; ++j) { const f32x4 w = *(const LAS f32x4*)(wab + c * 1024 + 256 * j + 4 * lane); p += (v[j].x * w.x + v[j].y * w.y) + (v[j].z * w.z + v[j].w * w.w); }
            p = wave_sum(p); if (lane == c) mine = p; }
        if (lane < 4) { const float xx = mine + a.in[12][lane]; const float sp = xx > 20.f ? xx : log1pf(expf(xx)); GG[t * 4 + lane] = -expf(a.in[11][lane]) * sp; }
        else if (lane < 8) GB[t * 4 + lane - 4] = 1.f / (1.f + expf(-mine));
    }
    rms_rows_bf16(a.in[1], a.in[18], WSP(bf16, WS_MEMN), NMEM, gw, NGW, lane);
    __syncthreads();
    prep_items(a, scr, lane, ITEMS_MOE + gw, NGW);
}

__device__ __forceinline__ void phase_gdn_prep(const Args& a, int lane, int gw, int NGW) {
    const float* cw = a.in[10];
    const bf16* PROJ = WSP(const bf16, WS_PROJ); bf16* GQKV = WSP(bf16, WS_GQKV);
    float w[3][4][8];
#pragma unroll
    for (int p = 0; p < 3; ++p)
#pragma unroll
        for (int j = 0; j < 4; ++j)
#pragma unroll
            for (int i = 0; i < 8; ++i) w[p][j][i] = cw[j * 1536 + 512 * p + 8 * lane + i];
    for (int t = gw; t < SEQ; t += NGW) {
#pragma unroll
        for (int p = 0; p < 3; ++p) {
            float acc[8];
#pragma unroll
            for (int i = 0; i < 8; ++i) acc[i] = 0.f;
#pragma unroll
            for (int j = 0; j < 4; ++j) { const int tt = t - 3 + j;
                if (tt >= 0) { const v4u raw = *(const v4u*)(PROJ + (size_t)tt * NPROJ + PC_QB + 512 * p + 8 * lane);
#pragma unroll
                    for (int i = 0; i < 4; ++i) { acc[2 * i] += w[p][j][2 * i] * bflo(raw[i]); acc[2 * i + 1] += w[p][j][2 * i + 1] * bfhi(raw[i]); } } }
            float ss = 0.f;
#pragma unroll
            for (int i = 0; i < 8; ++i) { acc[i] = siluf_(acc[i]); ss += acc[i] * acc[i]; }
            if (p < 2) { ss += __shfl_xor(ss, 1); ss += __shfl_xor(ss, 2); ss += __shfl_xor(ss, 4); ss += __shfl_xor(ss, 8);
                const float rn = rsqrtf(ss + EPS) * (p == 0 ? 0.08838834764831845f : 1.f);
#pragma unroll
                for (int i = 0; i < 8; ++i) acc[i] *= rn; }
            v4u o; o.x = pk2(acc[0], acc[1]); o.y = pk2(acc[2], acc[3]); o.z = pk2(acc[4], acc[5]); o.w = pk2(acc[6], acc[7]);
            *(v4u*)(GQKV + (size_t)t * 1536 + 512 * p + 8 * lane) = o;
        }
    }
}

__device__ __forceinline__ int t5_bucket(int rel) {
    const int ret = rel > 0 ? 16 : 0; const int n = rel < 0 ? -rel : rel;
    int large = 8 + (int)(logf((float)(n < 1 ? 1 : n) / 8.f) / 2.772588722239781f * 8.f);
    large = large < 15 ? large : 15;
    return ret + (n < 8 ? n : large);
}
__device__ __forceinline__ void attn_simple_unit(const Args& a, unsigned char* ldsg, int tid, int h, int qt, float lam) {
    float* Ks = (float*)ldsg;
    float* Vs = Ks + 8192;
    float* EX = (float*)ldsg;
    float* TAB = (float*)(ldsg + EXTRA_OFF);
    float* SSQ = TAB + 320;
    const bf16* PROJ = WSP(const bf16, WS_PROJ); const float* relb = a.in[4];
    const int q = tid & 127, map = (tid >> 7) & 1, half = tid >> 8;
    const int qpos = qt * 128 + q, qchunk = qpos >> 6;
    __syncthreads();
    if (tid < 319) TAB[tid] = relb[t5_bucket(tid - 255) * 4 + h];
    const float farb = relb[15 * 4 + h];
    float qv[64], acc[64];
    { const v4u* qp = (const v4u*)(PROJ + (size_t)qpos * NPROJ + PC_QA + h * 128 + map * 64);
#pragma unroll
      for (int i = 0; i < 8; ++i) { const v4u r = qp[i];
#pragma unroll
          for (int w = 0; w < 4; ++w) { qv[8 * i + 2 * w] = bflo(r[w]) * 0.125f; qv[8 * i + 2 * w + 1] = bfhi(r[w]) * 0.125f; } } }
#pragma unroll
    for (int d = 0; d < 64; ++d) acc[d] = 0.f;
    float m = -INFINITY, l = 0.f;
    const int nkt = 2 * qt + 2;
    for (int kt = 0; kt < nkt; ++kt) {
        __syncthreads();
        { const int key = tid >> 3, seg = tid & 7; const size_t row = (size_t)(kt * 64 + key) * NPROJ;
          const v4u* kp = (const v4u*)(PROJ + row + PC_KA + h * 128 + seg * 16); const v4u r0 = kp[0], r1 = kp[1];
          float* kd = Ks + ((seg >> 2) * 64 + key) * 64 + (seg & 3) * 16;
#pragma unroll
          for (int w = 0; w < 4; ++w) { kd[2 * w] = bflo(r0[w]); kd[2 * w + 1] = bfhi(r0[w]); kd[8 + 2 * w] = bflo(r1[w]); kd[8 + 2 * w + 1] = bfhi(r1[w]); }
          const v4u* vp = (const v4u*)(PROJ + row + PC_VA + h * 128 + seg * 16); const v4u s0 = vp[0], s1 = vp[1];
          float* vd = Vs + key * 128 + seg * 16;
#pragma unroll
          for (int w = 0; w < 4; ++w) { vd[2 * w] = bflo(s0[w]); vd[2 * w + 1] = bfhi(s0[w]); vd[8 + 2 * w] = bflo(s1[w]); vd[8 + 2 * w + 1] = bfhi(s1[w]); } }
        __syncthreads();
        if (kt <= qchunk) {
            const float* Kb = Ks + map * 4096;
#pragma unroll 1
            for (int j = 0; j < 64; ++j) {
                const f32x4* kr = (const f32x4*)(Kb + j * 64);
                float s = 0.f;
#pragma unroll
                for (int i = 0; i < 16; ++i) { const f32x4 k4 = kr[i]; s += (qv[4 * i] * k4.x + qv[4 * i + 1] * k4.y) + (qv[4 * i + 2] * k4.z + qv[4 * i + 3] * k4.w); if ((i & 3) == 3) asm volatile("" ::: "memory"); }
                const int rel = kt * 64 + j - qpos; s += rel < -255 ? farb : TAB[rel + 255];
                if (s > m) { const float f = __expf(m - s); l *= f;
#pragma unroll
                    for (int d = 0; d < 64; ++d) acc[d] *= f;
                    m = s; }
                const float p = __expf(s - m); l += p;
                const f32x4* vr = (const f32x4*)(Vs + j * 128 + half * 64);
#pragma unroll
                for (int i = 0; i < 16; ++i) { const f32x4 v4 = vr[i]; acc[4 * i] += p * v4.x; acc[4 * i + 1] += p * v4.y; acc[4 * i + 2] += p * v4.z; acc[4 * i + 3] += p * v4.w; if ((i & 3) == 3) asm volatile("" ::: "memory"); }
            }
        }
    }
    __syncthreads();
    const float inv = 1.f / l;
    if (map == 1) {
#pragma unroll
        for (int d = 0; d < 64; ++d) EX[q * 129 + half * 64 + d] = acc[d] * inv; }
    __syncthreads();
    if (map == 0) { float ss = 0.f;
#pragma unroll
        for (int d = 0; d < 64; ++d) { acc[d] = acc[d] * inv - lam * EX[q * 129 + half * 64 + d]; ss += acc[d] * acc[d]; }
        SSQ[q * 2 + half] = ss; }
    __syncthreads();
    if (map == 0) { const float r = rsqrtf((SSQ[q * 2] + SSQ[q * 2 + 1]) * (1.f / 128.f) + EPS) * 0.8f; const float* gs = a.in[9] + half * 64;
        bf16* op = WSP(bf16, WS_OA) + (size_t)qpos * 512 + h * 128 + half * 64;
#pragma unroll
        for (int i = 0; i < 8; ++i) { v4u o;
            o.x = pk2(acc[8 * i] * r * gs[8 * i], acc[8 * i + 1] * r * gs[8 * i + 1]); o.y = pk2(acc[8 * i + 2] * r * gs[8 * i + 2], acc[8 * i + 3] * r * gs[8 * i + 3]);
            o.z = pk2(acc[8 * i + 4] * r * gs[8 * i + 4], acc[8 * i + 5] * r * gs[8 * i + 5]); o.w = pk2(acc[8 * i + 6] * r * gs[8 * i + 6], acc[8 * i + 7] * r * gs[8 * i + 7]);
            *(v4u*)(op + 8 * i) = o; } }
}
__device__ __forceinline__ void gdn_scan_simple(const Args& a, unsigned char* ldsg, int tid, int h) {
    float* qs = (float*)ldsg; float* ks = qs + 8192; float* vs = ks + 8192;
    float* red = vs + 8192;
    float* gs = (float*)(ldsg + EXTRA_OFF); float* bs = gs + 64;
    const bf16* GQKV = WSP(const bf16, WS_GQKV); const float* GG = WSP(const float, WS_GG); const float* GB = WSP(const float, WS_GBETA); float* GO = WSP(float, WS_GO);
    const int e = tid & 127, dq = tid >> 7;
    float S[32];
#pragma unroll
    for (int d = 0; d < 32; ++d) S[d] = 0.f;
    for (int n = 0; n < 256; ++n) {
        __syncthreads();
        { const int row = tid >> 3, seg = tid & 7; const size_t t = (size_t)n * 64 + row;
#pragma unroll
          for (int p = 0; p < 3; ++p) { const v4u* sp = (const v4u*)(GQKV + t * 1536 + 512 * p + h * 128 + seg * 16); const v4u r0 = sp[0], r1 = sp[1];
              float* dp = (p == 0 ? qs : p == 1 ? ks : vs) + row * 128 + seg * 16;
#pragma unroll
              for (int w = 0; w < 4; ++w) { dp[2 * w] = bflo(r0[w]); dp[2 * w + 1] = bfhi(r0[w]); dp[8 + 2 * w] = bflo(r1[w]); dp[8 + 2 * w + 1] = bfhi(r1[w]); } } }
        if (tid < 64) { gs[tid] = GG[(n * 64 + tid) * 4 + h]; bs[tid] = GB[(n * 64 + tid) * 4 + h]; }
        __syncthreads();
#pragma unroll 1
        for (int i = 0; i < 64; ++i) {
            const float al = expf(gs[i]), be = bs[i];
            const f32x4* kr = (const f32x4*)(ks + i * 128 + dq * 32); const f32x4* qr = (const f32x4*)(qs + i * 128 + dq * 32);
            float kS = 0.f;
#pragma unroll
            for (int d4 = 0; d4 < 8; ++d4) { const f32x4 k4 = kr[d4];
                S[4 * d4] *= al; S[4 * d4 + 1] *= al; S[4 * d4 + 2] *= al; S[4 * d4 + 3] *= al;
                kS += (k4.x * S[4 * d4] + k4.y * S[4 * d4 + 1]) + (k4.z * S[4 * d4 + 2] + k4.w * S[4 * d4 + 3]); }
            red[dq * 128 + e] = kS;
            __syncthreads();
            const float kSt = (red[e] + red[128 + e]) + (red[256 + e] + red[384 + e]);
            const float vn = be * (vs[i * 128 + e] - kSt);
            float o = 0.f;
#pragma unroll
            for (int d4 = 0; d4 < 8; ++d4) { const f32x4 k4 = kr[d4]; const f32x4 q4 = qr[d4];
                S[4 * d4] += k4.x * vn; S[4 * d4 + 1] += k4.y * vn; S[4 * d4 + 2] += k4.z * vn; S[4 * d4 + 3] += k4.w * vn;
                o += (q4.x * S[4 * d4] + q4.y * S[4 * d4 + 1]) + (q4.z * S[4 * d4 + 2] + q4.w * S[4 * d4 + 3]); }
            red[512 + dq * 128 + e] = o;
            __syncthreads();
            if (dq == 0) GO[(size_t)(n * 64 + i) * 512 + h * 128 + e] = (red[512 + e] + red[640 + e]) + (red[768 + e] + red[896 + e]);
        }
    }
}
__device__ __forceinline__ void phase_mixers_simple(const Args& a, unsigned char* ldsg, int tid, int G, int bid) {
#ifndef NO_SCAN
    if (bid >= G - 4) { gdn_scan_simple(a, ldsg, tid, bid - (G - 4)); return; }
#endif
#ifndef NO_ATTN
    float s1 = 0.f, s2 = 0.f;
    for (int i = 0; i < 64; ++i) { s1 += a.in[5][i] * a.in[6][i]; s2 += a.in[7][i] * a.in[8][i]; }
    const float lam = expf(s1) - expf(s2) + 0.2f;
    for (int u = bid; u < 512; u += G - 4) attn_simple_unit(a, ldsg, tid, u & 3, 127 - (u >> 2), lam);
#endif
}

__device__ __forceinline__ void phase_gdn_post(const Args& a, int lane, int gw, int NGW) {
    const bf16* GO = WSP(const bf16, WS_GO); const bf16* PROJ = WSP(const bf16, WS_PROJ); bf16* OB = WSP(bf16, WS_OB); const float* gb = a.in[13];
    for (int t = gw; t < SEQ; t += NGW) {
        const v4u ov = *(const v4u*)(GO + (size_t)t * 512 + 8 * lane); const f32x4 o0 = {bflo(ov.x), bfhi(ov.x), bflo(ov.y), bfhi(ov.y)}, o1 = {bflo(ov.z), bfhi(ov.z), bflo(ov.w), bfhi(ov.w)};
        float ss = (o0.x * o0.x + o0.y * o0.y) + (o0.z * o0.z + o0.w * o0.w) + (o1.x * o1.x + o1.y * o1.y) + (o1.z * o1.z + o1.w * o1.w);
        ss += __shfl_xor(ss, 1); ss += __shfl_xor(ss, 2); ss += __shfl_xor(ss, 4); ss += __shfl_xor(ss, 8);
        const float r = rsqrtf(ss * (1.f / 128.f) + EPS);
        const v4u z = *(const v4u*)(PROJ + (size_t)t * NPROJ + PC_ZB + 8 * lane);
        const f32x4* gp = (const f32x4*)(gb + ((8 * lane) & 127)); const f32x4 g0 = gp[0], g1 = gp[1];
        v4u o;
        o.x = pk2(o0.x * r * g0.x * siluf_(bflo(z.x)), o0.y * r * g0.y * siluf_(bfhi(z.x))); o.y = pk2(o0.z * r * g0.z * siluf_(bflo(z.y)), o0.w * r * g0.w * siluf_(bfhi(z.y)));
        o.z = pk2(o1.x * r * g1.x * siluf_(bflo(z.z)), o1.y * r * g1.y * siluf_(bfhi(z.z))); o.w = pk2(o1.z * r * g1.z * siluf_(bflo(z.w)), o1.w * r * g1.w * siluf_(bfhi(z.w)));
        *(v4u*)(OB + (size_t)t * 512 + 8 * lane) = o;
    }
}

template <bool SECOND> struct EpiGate {
    static constexpr bool PERM = true, AFTER_DRAIN = false;
    const bf16* proj; bf16* mrg;
    __device__ __forceinline__ void operator()(const pg8::f32x4 (&acc)[2][2][4][2], const pg8::Unit& u, int wr, int wc, int fr, int fq) const {
        const int row0 = u.pm * 256 + wr * 64 + fr, col0 = u.pn * 256 + wc * 32 + 8 * fq;
#pragma unroll
        for (int ai = 0; ai < 2; ++ai)
#pragma unroll
            for (int m = 0; m < 4; ++m) { const size_t row = (size_t)(row0 + ai * 128 + m * 16);
#pragma unroll
                for (int bj = 0; bj < 2; ++bj) { const int col = col0 + bj * 128;
                    const v4u gr = *(const v4u*)(proj + row * NPROJ + (SECOND ? PC_GB : PC_GA) + col);
                    pg8::f32x4 v0 = acc[ai][bj][m][0], v1 = acc[ai][bj][m][1];
                    v0[0] *= bflo(gr.x); v0[1] *= bfhi(gr.x); v0[2] *= bflo(gr.y); v0[3] *= bfhi(gr.y);
                    v1[0] *= bflo(gr.z); v1[1] *= bfhi(gr.z); v1[2] *= bflo(gr.w); v1[3] *= bfhi(gr.w);
                    bf16* dst = mrg + row * DM + col;
                    if (SECOND) { const v4u pr = *(const v4u*)dst;
                        v0[0] += bflo(pr.x); v0[1] += bfhi(pr.x); v0[2] += bflo(pr.y); v0[3] += bfhi(pr.y); v1[0] += bflo(pr.z); v1[1] += bfhi(pr.z); v1[2] += bflo(pr.w); v1[3] += bfhi(pr.w); }
                    v4u o; o.x = pg8::cvt_pk_bf16(v0[0], v0[1]); o.y = pg8::cvt_pk_bf16(v0[2], v0[3]); o.z = pg8::cvt_pk_bf16(v1[0], v1[1]); o.w = pg8::cvt_pk_bf16(v1[2], v1[3]);
                    *(v4u*)dst = o; } }
    }
};
struct EpiResid {
    static constexpr bool PERM = true, AFTER_DRAIN = false;
    const float* base; float* out;
    __device__ __forceinline__ void operator()(const pg8::f32x4 (&acc)[2][2][4][2], const pg8::Unit& u, int wr, int wc, int fr, int fq) const {
        const int row0 = u.pm * 256 + wr * 64 + fr, col0 = u.pn * 256 + wc * 32 + 8 * fq;
#pragma unroll
        for (int ai = 0; ai < 2; ++ai)
#pragma unroll
            for (int m = 0; m < 4; ++m)
#pragma unroll
                for (int bj = 0; bj < 2; ++bj) { const size_t p = (size_t)(row0 + ai * 128 + m * 16) * DM + col0 + bj * 128;
                    const pg8::f32x4 b0 = *(const pg8::f32x4*)(base + p), b1 = *(const pg8::f32x4*)(base + p + 4);
                    *(pg8::f32x4*)(out + p) = b0 + acc[ai][bj][m][0]; *(pg8::f32x4*)(out + p + 4) = b1 + acc[ai][bj][m][1]; }
    }
};
constexpr size_t WS_X8 = WS_X1;
constexpr size_t WS_XB = WS_H;
constexpr size_t WS_SS = 690 * MiB + 1024 * 1024;
constexpr size_t WS_TOKR = 690 * MiB + 800 * 1024;
constexpr size_t WS_SLOTR = 774 * MiB, WS_SLOTT = 775 * MiB;
template <bool BF16_BASE> struct EpiResidStat {
    static constexpr bool PERM = true, AFTER_DRAIN = false;
    const float* basef; bf16* xb; float* ss; unsigned char* x8; float accs;
    __device__ __forceinline__ void operator()(const pg8::f32x4 (&acc)[2][2][4][2], const pg8::Unit& u, int wr, int wc, int fr, int fq) const {
        const int row0 = u.pm * 256 + wr * 64 + fr, col0 = u.pn * 256 + wc * 32 + 8 * fq;
#pragma unroll
        for (int ai = 0; ai < 2; ++ai)
#pragma unroll
            for (int m = 0; m < 4; ++m) { const int row = row0 + ai * 128 + m * 16; float s = 0.f;
#pragma unroll
                for (int bj = 0; bj < 2; ++bj) { const size_t p = (size_t)row * DM + col0 + bj * 128;
                    pg8::f32x4 v0, v1;
                    if (BF16_BASE) { const v4u b = *(const v4u*)(xb + p); v0 = (pg8::f32x4){bflo(b.x), bfhi(b.x), bflo(b.y), bfhi(b.y)}; v1 = (pg8::f32x4){bflo(b.z), bfhi(b.z), bflo(b.w), bfhi(b.w)}; }
                    else { v0 = *(const pg8::f32x4*)(basef + p); v1 = *(const pg8::f32x4*)(basef + p + 4); }
                    v0 = v0 + acc[ai][bj][m][0] * accs; v1 = v1 + acc[ai][bj][m][1] * accs;
                    s += (v0[0] * v0[0] + v0[1] * v0[1]) + (v0[2] * v0[2] + v0[3] * v0[3]) + (v1[0] * v1[0] + v1[1] * v1[1]) + (v1[2] * v1[2] + v1[3] * v1[3]);
                    v4u o; o.x = pg8::cvt_pk_bf16(v0[0], v0[1]); o.y = pg8::cvt_pk_bf16(v0[2], v0[3]); o.z = pg8::cvt_pk_bf16(v1[0], v1[1]); o.w = pg8::cvt_pk_bf16(v1[2], v1[3]);
                    *(v4u*)(xb + p) = o;
                    if (x8 != nullptr) { v2u o8; o8.x = pk4_fp8(v0[0], v0[1], v0[2], v0[3]); o8.y = pk4_fp8(v1[0], v1[1], v1[2], v1[3]); *(v2u*)(x8 + p) = o8; } }
                s += __shfl_xor(s, 16); s += __shfl_xor(s, 32);
                if (fq == 0) ss[(size_t)row * 16 + u.pn * 4 + wc] = s; }
    }
};
__device__ __forceinline__ float row_rstd(const float* ss, size_t row) {
    const pg8::f32x4* p = (const pg8::f32x4*)(ss + row * 16); const pg8::f32x4 a = p[0], b = p[1], c = p[2], d = p[3];
    return rsqrtf((((a[0] + a[1]) + (a[2] + a[3])) + ((b[0] + b[1]) + (b[2] + b[3])) + ((c[0] + c[1]) + (c[2] + c[3])) + ((d[0] + d[1]) + (d[2] + d[3]))) * (1.f / DM) + EPS);
}
struct EpiRowScale {
    static constexpr bool PERM = true, AFTER_DRAIN = false;
    bf16* O; const float* ss;
    __device__ __forceinline__ void operator()(const pg8::f32x4 (&acc)[2][2][4][2], const pg8::Unit& u, int wr, int wc, int fr, int fq) const {
        const int row0 = u.pm * 256 + wr * 64 + fr, col0 = u.pn * 256 + wc * 32 + 8 * fq;
#pragma unroll
        for (int ai = 0; ai < 2; ++ai)
#pragma unroll
            for (int m = 0; m < 4; ++m) { const size_t row = (size_t)(row0 + ai * 128 + m * 16); const float r = row_rstd(ss, row) * (FP8_X ? 1.f / W8_SCALE : 1.f);
#pragma unroll
                for (int bj = 0; bj < 2; ++bj) { const pg8::f32x4 v0 = acc[ai][bj][m][0] * r, v1 = acc[ai][bj][m][1] * r;
                    v4u o; o.x = pg8::cvt_pk_bf16(v0[0], v0[1]); o.y = pg8::cvt_pk_bf16(v0[2], v0[3]); o.z = pg8::cvt_pk_bf16(v1[0], v1[1]); o.w = pg8::cvt_pk_bf16(v1[2], v1[3]);
                    *(v4u*)(O + row * DM + col0 + bj * 128) = o; } }
    }
};
struct EpiSwiglu {
    static constexpr bool PERM = true, AFTER_DRAIN = false;
    bf16* act; const float* b1; const float* rr;
    __device__ __forceinline__ void operator()(const pg8::f32x4 (&acc)[2][2][4][2], const pg8::Unit& u, int wr, int wc, int fr, int fq) const {
        const int e = u.pn >> 3, j = u.pn & 7; const int row0 = u.pm * 256 + wr * 64 + fr, c0 = 128 * j + wc * 32 + 8 * fq;
        const float* bg = b1 + (size_t)e * 2048 + c0; const float* bl = bg + 1024;
#pragma unroll
        for (int ai = 0; ai < 2; ++ai)
#pragma unroll
            for (int m = 0; m < 4; ++m) { const size_t row = (size_t)(row0 + ai * 128 + m * 16); const float rs = rr[row] * (MOE_F8 ? 1.f / W8_SCALE : 1.f);
                asm volatile("" ::: "memory");
                const pg8::f32x4 bg0 = *(const pg8::f32x4*)bg, bg1 = *(const pg8::f32x4*)(bg + 4), bl0 = *(const pg8::f32x4*)bl, bl1 = *(const pg8::f32x4*)(bl + 4);
                const pg8::f32x4 g0 = acc[ai][0][m][0] * rs + bg0,     g1 = acc[ai][0][m][1] * rs + bg1, l0 = acc[ai][1][m][0] * rs + bl0, l1 = acc[ai][1][m][1] * rs + bl1;
                float r[8];
#pragma unroll
                for (int i = 0; i < 4; ++i) { const float ga = fminf(g0[i], 7.f), la = fminf(fmaxf(l0[i], -7.f), 7.f); r[i] = ga * sigmoidf_(1.702f * ga) * (la + 1.f);
                    const float gb = fminf(g1[i], 7.f), lb = fminf(fmaxf(l1[i], -7.f), 7.f); r[4 + i] = gb * sigmoidf_(1.702f * gb) * (lb + 1.f); }
                if (MOE_F8) { v2u o; o.x = pk4_fp8(r[0], r[1], r[2], r[3]); o.y = pk4_fp8(r[4], r[5], r[6], r[7]); *(v2u*)((unsigned char*)act + row * 1024 + c0) = o; }
                else { v4u o; o.x = pg8::cvt_pk_bf16(r[0], r[1]); o.y = pg8::cvt_pk_bf16(r[2], r[3]); o.z = pg8::cvt_pk_bf16(r[4], r[5]); o.w = pg8::cvt_pk_bf16(r[6], r[7]);
                    *(v4u*)(act + row * 1024 + c0) = o; } }
    }
};
struct EpiMoeOut {
    static constexpr bool PERM = true, AFTER_DRAIN = false;
    bf16* ys; const float* b2; const float* sw;
    __device__ __forceinline__ void operator()(const pg8::f32x4 (&acc)[2][2][4][2], const pg8::Unit& u, int wr, int wc, int fr, int fq) const {
        const int e = u.pn >> 2; const int row0 = u.pm * 256 + wr * 64 + fr, col0 = (u.pn & 3) * 256 + wc * 32 + 8 * fq;
        pg8::f32x4 bv[2][2];
#pragma unroll
        for (int bj = 0; bj < 2; ++bj) { bv[bj][0] = *(const pg8::f32x4*)(b2 + (size_t)e * 1024 + col0 + bj * 128); bv[bj][1] = *(const pg8::f32x4*)(b2 + (size_t)e * 1024 + col0 + bj * 128 + 4); }
#pragma unroll
        for (int ai = 0; ai < 2; ++ai)
#pragma unroll
            for (int m = 0; m < 4; ++m) { const size_t row = (size_t)(row0 + ai * 128 + m * 16); const float w = sw[row];
#pragma unroll
                for (int bj = 0; bj < 2; ++bj) { const float ws = MOE_F8 ? 1.f / W8_SCALE : 1.f; const pg8::f32x4 v0 = (acc[ai][bj][m][0] * ws + bv[bj][0]) * w, v1 = (acc[ai][bj][m][1] * ws + bv[bj][1]) * w;
                    v4u o; o.x = pg8::cvt_pk_bf16(v0[0], v0[1]); o.y = pg8::cvt_pk_bf16(v0[2], v0[3]); o.z = pg8::cvt_pk_bf16(v1[0], v1[1]); o.w = pg8::cvt_pk_bf16(v1[2], v1[3]);
                    *(v4u*)(ys + row * 1024 + col0 + bj * 128) = o; } }
    }
};
struct MoeOrder {
    int G, c, NT, nunits; const LAS int* blk_e;
    __device__ __forceinline__ bool next(int i, pg8::Unit& u) const {
        const int chunk = (nunits + 7) >> 3, ul = i * (G >> 3) + (c >> 3); if (ul >= chunk) return false;
        const int s = (c & 7) * chunk + ul; if (s >= nunits) return false;
        const int rb = s / NT, nt = s - rb * NT; u.pm = rb; u.pn = __builtin_amdgcn_readfirstlane(blk_e[rb]) * NT + nt; return true; }
    __device__ __forceinline__ void a_ready(const pg8::Unit&) const {}
    __device__ __forceinline__ void done(const pg8::Unit&) const {}
};

__device__ __forceinline__ void phase_xattn_simple(const Args& a, unsigned char* ldsg, int tid, int G, int bid) {
    float* qt = (float*)ldsg;
    float* sc = qt + 16384;
    float* pt = sc + 8192;
    const bf16* QX = WSP(const bf16, WS_QX); const bf16* KVX = WSP(const bf16, WS_KVX); bf16* OX = WSP(bf16, WS_OX);
    const int j = tid & 255, hs = tid >> 8;
    for (int grp = bid; grp < SEQ / 16; grp += G) {
        __syncthreads();
        { const int row = tid >> 5, seg = tid & 31; const v4u* sp = (const v4u*)(QX + (size_t)(grp * 16 + row) * DM + seg * 32); float* dp = qt + row * 1024 + seg * 32;
#pragma unroll
          for (int i = 0; i < 4; ++i) { const v4u r = sp[i];
#pragma unroll
              for (int w = 0; w < 4; ++w) { dp[8 * i + 2 * w] = bflo(r[w]); dp[8 * i + 2 * w + 1] = bfhi(r[w]); } } }
        __syncthreads();
        for (int it = 0; it < 2; ++it) { const int hh = hs + 2 * it;
            float s[16];
#pragma unroll
            for (int tok = 0; tok < 16; ++tok) s[tok] = 0.f;
            const bf16* kp = KVX + (size_t)j * 2048 + hh * 256;
#pragma unroll 2
            for (int p = 0; p < 32; ++p) { const v4u kr = *(const v4u*)(kp + 8 * p);
                const float k0 = bflo(kr.x), k1 = bfhi(kr.x), k2 = bflo(kr.y), k3 = bfhi(kr.y), k4 = bflo(kr.z), k5 = bfhi(kr.z), k6 = bflo(kr.w), k7 = bfhi(kr.w);
#pragma unroll
                for (int tok = 0; tok < 16; ++tok) { const f32x4* q4 = (const f32x4*)(qt + tok * 1024 + hh * 256 + 8 * p); const f32x4 qa = q4[0], qb = q4[1];
                    s[tok] += (qa.x * k0 + qa.y * k1) + (qa.z * k2 + qa.w * k3) + (qb.x * k4 + qb.y * k5) + (qb.z * k6 + qb.w * k7); } }
#pragma unroll
            for (int tok = 0; tok < 16; ++tok) sc[(hs * 16 + tok) * 256 + j] = s[tok] * 0.0625f;
            __syncthreads();
            { const int tok = (tid & 255) >> 4, part = tid & 15; const float* sr = sc + (hs * 16 + tok) * 256 + part * 16;
              float v[16]; float mx = -INFINITY;
#pragma unroll
              for (int i = 0; i < 16; ++i) { v[i] = sr[i]; mx = fmaxf(mx, v[i]); }
              mx = fmaxf(mx, __shfl_xor(mx, 1)); mx = fmaxf(mx, __shfl_xor(mx, 2)); mx = fmaxf(mx, __shfl_xor(mx, 4)); mx = fmaxf(mx, __shfl_xor(mx, 8));
              float sm = 0.f;
#pragma unroll
              for (int i = 0; i < 16; ++i) { v[i] = __expf(v[i] - mx); sm += v[i]; }
              sm += __shfl_xor(sm, 1); sm += __shfl_xor(sm, 2); sm += __shfl_xor(sm, 4); sm += __shfl_xor(sm, 8);
              const float inv = 1.f / sm;
#pragma unroll
              for (int i = 0; i < 16; ++i) pt[(hs * 256 + part * 16 + i) * 16 + tok] = v[i] * inv; }
            __syncthreads();
            { float o[16];
#pragma unroll
              for (int tok = 0; tok < 16; ++tok) o[tok] = 0.f;
              const bf16* vp = KVX + 1024 + hh * 256 + j;
#pragma unroll 4
              for (int jj = 0; jj < 256; ++jj) { const float v = bf2f(vp[(size_t)jj * 2048]); const f32x4* p4 = (const f32x4*)(pt + (hs * 256 + jj) * 16);
#pragma unroll
                  for (int c = 0; c < 4; ++c) { const f32x4 pp = p4[c]; o[4 * c] += pp.x * v; o[4 * c + 1] += pp.y * v; o[4 * c + 2] += pp.z * v; o[4 * c + 3] += pp.w * v; } }
#pragma unroll
              for (int tok = 0; tok < 16; ++tok) OX[(size_t)(grp * 16 + tok) * DM + hh * 256 + j] = (bf16)f2bf(o[tok]); }
        }
    }
}

__device__ __forceinline__ void phase_router(const Args& a, unsigned char* ldsg, int lane, int wave, int gw, int NGW) {
    const bf16* X2 = WSP(const bf16, WS_XB); const float* Wr = a.in[23]; const float* br = a.in[24];
    int* TOPE = WSP(int, WS_TOPE); float* TOPW = WSP(float, WS_TOPW); unsigned* cnt = WSP(unsigned, WS_CTL) + CW_CNT;
    float* hT = (float*)ldsg + wave * 4096;
    const int e = lane & 31, kh = lane >> 5;
    { int* SLOTT = WSP(int, WS_SLOTT); for (int i = gw * 64 + lane; i < 73728; i += NGW * 64) SLOTT[i] = 0; }
    const float bre = br[e];
    for (int t0 = gw * 4; t0 < SEQ; t0 += NGW * 4) {
#pragma unroll
        for (int r = 0; r < 4; ++r) { f32x4 v[4]; const float rstd = rms_row_load_bf16(X2 + (size_t)(t0 + r) * DM, a.in[22], lane, v); if (lane == 0) WSP(float, WS_TOKR)[t0 + r] = rstd;
#pragma unroll
            for (int j = 0; j < 4; ++j)
#pragma unroll
                for (int c = 0; c < 4; ++c) hT[(4 * lane + 256 * j + c) * 4 + r] = v[j][c]; }
        LDS_WAIT(); asm volatile("" ::: "memory");
        float p[4] = {0.f, 0.f, 0.f, 0.f};
        const float* wp = Wr + (size_t)(kh * 512) * 32 + e; const f32x4* hp = (const f32x4*)hT + kh * 512;
#pragma unroll 8
        for (int k = 0; k < 512; ++k) { const float w = wp[(size_t)k * 32]; const f32x4 h4 = hp[k]; p[0] += h4.x * w; p[1] += h4.y * w; p[2] += h4.z * w; p[3] += h4.w * w; }
#pragma unroll
        for (int r = 0; r < 4; ++r) { const int t = t0 + r;
            float pr = p[r] + __shfl_xor(p[r], 32);
            float mine = (lane < 32) ? pr + bre : -INFINITY;
            float tv[4]; int te[4];
#pragma unroll
            for (int q = 0; q < 4; ++q) { float bv = mine; int bi = lane;
#pragma unroll
                for (int o = 1; o < 64; o <<= 1) { const float ov = __shfl_xor(bv, o); const int oi = __shfl_xor(bi, o); if (ov > bv || (ov == bv && oi < bi)) { bv = ov; bi = oi; } }
                tv[q] = bv; te[q] = bi; if (lane == bi) mine = -INFINITY; }
            const float e1 = expf(tv[1] - tv[0]), e2 = expf(tv[2] - tv[0]), e3 = expf(tv[3] - tv[0]); const float inv = 1.f / (1.f + e1 + e2 + e3);
            if (lane < 4) { const int ee = lane == 0 ? te[0] : lane == 1 ? te[1] : lane == 2 ? te[2] : te[3]; const float ww = (lane == 0 ? 1.f : lane == 1 ? e1 : lane == 2 ? e2 : e3) * inv;
                TOPE[t * 4 + lane] = ee; TOPW[t * 4 + lane] = ww; atomicAdd(&cnt[(t >> 6) * 32 + ee], 1u); } }
        asm volatile("" ::: "memory");
    }
}

__device__ __forceinline__ void moe_tables(const Args& a, unsigned char* ldsg, int tid, int myblk) {
    const unsigned* cnt = WSP(const unsigned, WS_CTL) + CW_CNT;
    int* part_tot = (int*)ldsg; int* part_bef = part_tot + 512; int* X = (int*)(ldsg + EXTRA_OFF);
    __syncthreads();
    { const int e = tid & 31, part = tid >> 5; int st = 0, sb = 0;
      for (int b = part * 16; b < part * 16 + 16; ++b) { const int c = (int)__hip_atomic_load(&cnt[b * 32 + e], RLX_AGENT); st += c; sb += (b < myblk) ? c : 0; }
      part_tot[part * 32 + e] = st; part_bef[part * 32 + e] = sb; }
    __syncthreads();
    if (tid < 32) { int t = 0, b = 0; for (int p = 0; p < 16; ++p) { t += part_tot[p * 32 + tid]; b += part_bef[p * 32 + tid]; } X[tid] = t; X[32 + tid] = b; }
    __syncthreads();
    if (tid == 0) { int nb = 0; for (int e = 0; e < 32; ++e) { X[64 + e] = nb * 256; const int k = (X[e] + 255) >> 8; for (int i = 0; i < k; ++i) X[128 + nb + i] = e; nb += k; } X[96] = nb; }
    __syncthreads();
}
__device__ __forceinline__ void phase_slots(const Args& a, unsigned char* ldsg, int tid, int lane, int wave, int G, int bid) {
    const int* TOPE = WSP(const int, WS_TOPE); const float* TOPW = WSP(const float, WS_TOPW); int* SPOS = WSP(int, WS_SPOS); float* SLOTW = WSP(float, WS_SLOTW);
    const bf16* H = WSP(const bf16, WS_XB); bf16* XS = WSP(bf16, WS_XS); const float* TOKR = WSP(const float, WS_TOKR); float* SLOTR = WSP(float, WS_SLOTR);
    int* X = (int*)(ldsg + EXTRA_OFF); int* posl = (int*)(ldsg + 8192);
    for (int blk = bid; blk < SEQ / 64; blk += G) {
        moe_tables(a, ldsg, tid, blk);
        if (wave == 0) { const int t = blk * 64 + lane; int sofar_mine = 0;
            for (int k = 0; k < 4; ++k) { const int ek = TOPE[t * 4 + k]; int pos = 0;
                for (int ee = 0; ee < 32; ++ee) { const unsigned long long mk = __ballot(ek == ee); const int c = __popcll(mk); const int before = __popcll(mk & ((1ull << lane) - 1ull)); const int sofar = __shfl(sofar_mine, ee);
                    if (ek == ee) pos = X[64 + ee] + X[32 + ee] + sofar + before; if (lane == ee) sofar_mine += c; }
                SPOS[t * 4 + k] = pos; SLOTW[pos] = TOPW[t * 4 + k]; SLOTR[pos] = TOKR[t]; WSP(int, WS_SLOTT)[pos] = t; } }
    }
}

__device__ __forceinline__ void phase_final(const Args& a, int lane, int gw, int NGW) {
    const bf16* X2 = WSP(const bf16, WS_XB); const int* SPOS = WSP(const int, WS_SPOS); const bf16* YS = WSP(const bf16, WS_YS); const float* g = a.in[29];
    for (int t = gw; t < SEQ; t += NGW) {
        const v2u* xr = (const v2u*)(X2 + (size_t)t * DM) + lane; f32x4 v[4];
#pragma unroll
        for (int j = 0; j < 4; ++j) { const v2u r = xr[64 * j]; v[j] = (f32x4){bflo(r.x), bfhi(r.x), bflo(r.y), bfhi(r.y)}; }
#pragma unroll
        for (int k = 0; k < 4; ++k) { const int pos = SPOS[t * 4 + k]; const v2u* yr = (const v2u*)(YS + (size_t)pos * DM) + lane;
#pragma unroll
            for (int j = 0; j < 4; ++j) { const v2u r = yr[64 * j]; v[j].x += bflo(r.x); v[j].y += bfhi(r.x); v[j].z += bflo(r.y); v[j].w += bfhi(r.y); } }
        float s = 0.f;
#pragma unroll
        for (int j = 0; j < 4; ++j) s += (v[j].x * v[j].x + v[j].y * v[j].y) + (v[j].z * v[j].z + v[j].w * v[j].w);
        const float rstd = rsqrtf(wave_sum(s) * (1.f / DM) + EPS);
        f32x4* orow = (f32x4*)(a.out + (size_t)t * DM) + lane;
#pragma unroll
        for (int j = 0; j < 4; ++j) { const f32x4 gv = ((const f32x4*)g)[lane + 64 * j]; orow[64 * j] = v[j] * rstd * gv; }
    }
}


namespace att {
using bf16x8 = __attribute__((ext_vector_type(8))) short;
using s16x4 = __attribute__((ext_vector_type(4))) short;
using f32x16 = __attribute__((ext_vector_type(16))) float;
typedef short v4i16_t __attribute__((ext_vector_type(4)));
using u32x4_t = __attribute__((ext_vector_type(4))) unsigned;
typedef float f32x2_t __attribute__((ext_vector_type(2))); typedef __bf16 bf16x2_t __attribute__((ext_vector_type(2)));
constexpr int SLOT = 32768, OFF_K = 0, OFF_V = 16384;
constexpr int LDS_WS = 98304;
constexpr int LDS_WS2 = EXTRA_OFF + 5376;
constexpr int TAB_OFF = EXTRA_OFF;
constexpr float LOG2E = 1.4426950408889634f, C2 = 0.125f * 1.4426950408889634f;
__device__ __forceinline__ int crow(int r, int hi) { return (r & 3) + 8 * (r >> 2) + 4 * hi; }
__device__ __forceinline__ void glds16(const void* gsrc, unsigned lds_dst) { unsigned keep;
    asm volatile("s_mov_b32 %0, m0\n\ts_mov_b32 m0, %2\n\ts_nop 0\n\tglobal_load_lds_dwordx4 %1, off\n\ts_mov_b32 m0, %0" : "=&s"(keep) : "v"(gsrc), "s"(lds_dst) : "memory"); }
__device__ __forceinline__ unsigned cvtpk_s(float lo, float hi) { f32x2_t v = {lo, hi}; bf16x2_t b = __builtin_convertvector(v, bf16x2_t); return __builtin_bit_cast(unsigned, b); }
__device__ __forceinline__ s16x4 vtr(const LAS char* p) { return __builtin_bit_cast(s16x4, __builtin_amdgcn_ds_read_tr16_b64_v4i16((LAS v4i16_t*)p)); }
__device__ __forceinline__ float max3f(float a, float b, float c) { float r; asm("v_max3_f32 %0, %1, %2, %3" : "=v"(r) : "v"(a), "v"(b), "v"(c)); return r; }
#define ATT_WAIT_BAR_(N) asm volatile("s_waitcnt vmcnt(" #N ") lgkmcnt(0)\n\ts_barrier" ::: "memory")
#define ATT_WAIT_BAR(N) ATT_WAIT_BAR_(N)
#if PV_F8
#define ATT_NV 3
#else
#define ATT_NV 4
#endif
typedef int v2i32_t __attribute__((ext_vector_type(2)));
__device__ __forceinline__ int pk4_fp8a(float a, float b, float c, float d) { int w; asm("v_cvt_pk_fp8_f32 %0, %1, %2" : "=v"(w) : "v"(a), "v"(b)); asm("v_cvt_pk_fp8_f32 %0, %1, %2 op_sel:[0,0,1]" : "+v"(w) : "v"(c), "v"(d)); return w; }
__device__ __forceinline__ v2i32_t vtr8(const LAS char* p) { return __builtin_amdgcn_ds_read_tr8_b64_v2i32((LAS v2i32_t*)p); }
#define ATT_BAR_PLAIN() asm volatile("s_waitcnt lgkmcnt(0)\n\ts_barrier" ::: "memory")

__device__ __forceinline__ void build_tables(const Args& a, LAS unsigned char* L, int tid) {
    LAS float* TAB = (LAS float*)(L + TAB_OFF);
    for (int i = tid; i < 4 * 320; i += NTHR) { const int h = i / 320, j = i - h * 320; TAB[i] = j < 319 ? (a.in[4][t5_bucket(j - 255) * 4 + h] - a.in[4][15 * 4 + h]) * LOG2E : 0.f; }
    if (tid < 4) TAB[1280 + tid] = a.in[4][15 * 4 + tid] * LOG2E;
    __syncthreads();
}

#ifndef ATT_COMPL
#define ATT_COMPL 1
#endif
#ifndef ATT_AHALF
#define ATT_AHALF 0
#endif
#ifndef ATT_PRIO
#define ATT_PRIO 0
#endif
#ifndef ATT_LAGSH
#define ATT_LAGSH 0
#endif
template <int THRL, int ABL = 0, bool STAG = false>
__device__ __forceinline__ void attn_unit(const Args& a, LAS unsigned char* L, int h, int qt, float lam) {
    const int tid = threadIdx.x, lane = tid & 63, r32 = lane & 31, hi = lane >> 5;
    const int wid = __builtin_amdgcn_readfirstlane(tid >> 6), rg = wid & 3, map = wid >> 2;
    const bf16* PROJ = WSP(const bf16, WS_PROJ);
    const int q0w = qt * 128 + rg * 32, mychunk = 2 * qt + (rg >> 1), nkt = 2 * qt + 2;
    const unsigned lds0 = (unsigned)(uintptr_t)L;
    LAS float* wsf = (LAS float*)(L + (STAG ? LDS_WS2 : LDS_WS)) + wid * 64;
    const LAS float* TAB = (const LAS float*)(L + TAB_OFF);
    const float farb2 = TAB[1280 + h];
    const int krow = 8 * wid + (lane >> 3);
    const bf16* ksrc0 = PROJ + (size_t)krow * NPROJ + PC_KA + h * 128 + (((lane & 7) ^ ((krow >> 1) & 7)) * 8);
    const bf16* vsrc0 = PROJ + (size_t)(16 * (wid & 3) + (lane >> 2)) * NPROJ + PC_VA + h * 128 + (wid >> 2) * 32 + (lane & 3) * 8;
    const unsigned kdst = lds0 + OFF_K + wid * 1024, vdst = lds0 + OFF_V + wid * 1024;
#if PV_F8
    const unsigned char* vsrc8 = (const unsigned char*)a.ws + WS_VIMG + (size_t)h * 256 * 8192 + wid * 1024 + lane * 16;
#define ATT_DMA(t, so) do { const size_t ro_ = (size_t)(t) * 64 * NPROJ; \
        glds16(ksrc0 + ro_, (unsigned)__builtin_amdgcn_readfirstlane(kdst + (so))); glds16(ksrc0 + ro_ + 64, (unsigned)__builtin_amdgcn_readfirstlane(kdst + (so) + 8192)); \
        glds16(vsrc8 + (size_t)(t) * 8192, (unsigned)__builtin_amdgcn_readfirstlane(vdst + (so))); } while (0)
#else
#define ATT_DMA(t, so) do { const size_t ro_ = (size_t)(t) * 64 * NPROJ; \
        glds16(ksrc0 + ro_, (unsigned)__builtin_amdgcn_readfirstlane(kdst + (so))); glds16(ksrc0 + ro_ + 64, (unsigned)__builtin_amdgcn_readfirstlane(kdst + (so) + 8192)); \
        glds16(vsrc0 + ro_, (unsigned)__builtin_amdgcn_readfirstlane(vdst + (so))); glds16(vsrc0 + ro_ + 64, (unsigned)__builtin_amdgcn_readfirstlane(vdst + (so) + 8192)); } while (0)
#endif
    constexpr float PO = PV_F8 ? 8.f : 0.f, THRF = PV_F8 ? 0.5f : (float)THRL;
    asm volatile("s_waitcnt vmcnt(0)" ::: "memory");
    if (ABL != 4 && ABL != 9 && ABL != 10 && ABL != 11) { ATT_DMA(0, 0); ATT_DMA(1, SLOT); }
    const int lagw = (wid >> ATT_LAGSH) & 1;
    if (STAG && lagw == 1) { ATT_WAIT_BAR(4); }
    bf16x8 qr[4];
    { const bf16* Qw = PROJ + (size_t)(q0w + r32) * NPROJ + PC_QA + h * 128 + map * 64 + hi * 8;
#pragma unroll
      for (int d0 = 0; d0 < 4; ++d0) qr[d0] = *reinterpret_cast<const bf16x8*>(Qw + d0 * 16); }
    asm volatile("" : "+v"(qr[0]), "+v"(qr[1]), "+v"(qr[2]), "+v"(qr[3]));
    float mhat = 0.f, l = 0.f;
    f32x16 o[4];
#pragma unroll
    for (int d0 = 0; d0 < 4; ++d0) o[d0] = f32x16{};
    f32x16 cinF;
#pragma unroll
    for (int r = 0; r < 16; ++r) cinF[r] = farb2;
    int so_cur = 0, so_nn = 2 * SLOT;
    const LAS char* vbase8 = (const LAS char*)L + OFF_V + (lane >> 5) * 256 + ((lane & 15) >> 1) * 32 + ((lane >> 4) & 1) * 16 + (lane & 1) * 8;
    pg8::i32x8_ pa8, vb8[4];
    const LAS char* kbase = (const LAS char*)L + OFF_K + map * 8192 + r32 * 128;
    int koff[4];
#pragma unroll
    for (int j = 0; j < 4; ++j) koff[j] = (((2 * j + hi) ^ ((r32 >> 1) & 7)) * 16);
    const LAS char* vbase = (const LAS char*)L + OFF_V + ((lane >> 4) & 1) * 32 + (lane & 3) * 8 + (4 * hi + ((lane & 15) >> 2)) * 64;
    u32x4_t pw[4];
    for (int kt = 0; kt < nkt; ++kt) {
        if (ABL != 7 && ABL != 9 && ABL != 10 && ABL != 11) { if (kt + 1 < nkt) { ATT_WAIT_BAR(ATT_NV); } else { ATT_WAIT_BAR(0); } }
        if (ABL != 4 && ABL != 7 && ABL != 9 && ABL != 10 && ABL != 11) { if (kt + 2 < nkt) ATT_DMA(kt + 2, so_nn); }
        if (kt <= mychunk) {
            const LAS char* kp = kbase + so_cur;
            bf16x8 kf[8];
#pragma unroll
            for (int j = 0; j < ((ABL == 6 || ABL == 8 || ABL == 9 || ABL == 11) ? 0 : 4); ++j) { kf[2 * j] = *(const LAS bf16x8*)(kp + koff[j]); kf[2 * j + 1] = *(const LAS bf16x8*)(kp + koff[j] + 4096); }
            if (ABL == 0) asm volatile("" : "+v"(kf[0]), "+v"(kf[1]), "+v"(kf[2]), "+v"(kf[3]), "+v"(kf[4]), "+v"(kf[5]), "+v"(kf[6]), "+v"(kf[7]));
            const bool far = (kt * 64 + 63 - q0w) <= -128;
            const f32x16 cin = cinF;
            f32x16 p0 = cin, p1 = cin;
            if (ABL != 6 && ABL != 11 && (ABL < 8 || ABL == 10)) { p0 = __builtin_amdgcn_mfma_f32_32x32x16_bf16(kf[0], qr[0], cin, 0, 0, 0);
            p1 = __builtin_amdgcn_mfma_f32_32x32x16_bf16(kf[1], qr[0], cin, 0, 0, 0); }
#pragma unroll
            for (int d0 = 1; d0 < ((ABL == 6 || ABL == 8 || ABL == 9 || ABL == 11) ? 1 : 4); ++d0) { p0 = __builtin_amdgcn_mfma_f32_32x32x16_bf16(kf[2 * d0], qr[d0], p0, 0, 0, 0); p1 = __builtin_amdgcn_mfma_f32_32x32x16_bf16(kf[2 * d0 + 1], qr[d0], p1, 0, 0, 0); }
            if (PV_F8 && !(ABL == 2 || ABL == 8 || ABL == 9 || ABL == 11)) { const LAS char* vp = vbase8 + so_cur;
#pragma unroll
                for (int db = 0; db < 4; ++db)
#pragma unroll
                    for (int j = 0; j < 4; ++j) { const v2i32_t t = vtr8(vp + db * 2048 + j * 512); vb8[db][2 * j] = t[0]; vb8[db][2 * j + 1] = t[1]; } }
            if (!far) { const LAS float* tb = TAB + h * 320 + 255 + kt * 64 - (q0w + r32) + 4 * hi;
#pragma unroll
                for (int r = 0; r < 16; ++r) { p0[r] += tb[(r & 3) + 8 * (r >> 2)]; p1[r] += tb[32 + (r & 3) + 8 * (r >> 2)]; } }
            float sacc = 0.f; bool resc = false;
            if (ABL != 5 && ABL != 10 && (ABL < 8 || ABL == 11)) {
            float rma = max3f(p0[0], p0[1], p1[0]), rmb = max3f(p0[2], p0[3], p1[1]); rma = max3f(rma, p1[2], p1[3]);
#pragma unroll
            for (int r = 4; r < 16; r += 4) { rma = max3f(rma, p0[r], p0[r + 1]); rmb = max3f(rmb, p0[r + 2], p0[r + 3]); rma = max3f(rma, p1[r], p1[r + 1]); rmb = max3f(rmb, p1[r + 2], p1[r + 3]); }
            float rm = max3f(rma, rmb, rmb);
            { auto rr = __builtin_amdgcn_permlane32_swap(__float_as_uint(rm), __float_as_uint(rm), false, false); rm = max3f(__uint_as_float(rr[0]), __uint_as_float(rr[1]), __uint_as_float(rr[1])); }
            if (kt == 0 || __any(rm > THRF + PO)) {
                const float dl = (kt == 0) ? rm - PO : fmaxf(rm - PO, 0.f); mhat += dl;
#pragma unroll
                for (int r = 0; r < 16; ++r) { p0[r] -= dl; p1[r] -= dl; }
                const float f = __builtin_amdgcn_exp2f(-dl); l *= f; if (hi == 0) wsf[r32] = f; resc = (kt != 0);
#pragma unroll
                for (int r = 0; r < 16; ++r) cinF[r] = farb2 - mhat; }
#pragma unroll
            for (int r = 0; r < 16; ++r) { if (ABL != 1) { p0[r] = __builtin_amdgcn_exp2f(p0[r]); p1[r] = __builtin_amdgcn_exp2f(p1[r]); } sacc += p0[r] + p1[r]; }
            }
            l += sacc;
            if (resc) { asm volatile("s_waitcnt lgkmcnt(0)" ::: "memory");
#pragma unroll
                for (int r = 0; r < 16; ++r) { const float f = wsf[crow(r, hi)];
#pragma unroll
                    for (int d0 = 0; d0 < 4; ++d0) o[d0][r] *= f; } }
            if (PV_F8) {
#pragma unroll
                for (int g = 0; g < 4; ++g) { pa8[g] = pk4_fp8a(p0[4 * g], p0[4 * g + 1], p0[4 * g + 2], p0[4 * g + 3]); pa8[4 + g] = pk4_fp8a(p1[4 * g], p1[4 * g + 1], p1[4 * g + 2], p1[4 * g + 3]); }
            } else {
#pragma unroll
            for (int w = 0; w < 4; ++w) { pw[0][w] = cvtpk_s(p0[2 * w], p0[2 * w + 1]); pw[1][w] = cvtpk_s(p0[8 + 2 * w], p0[8 + 2 * w + 1]); pw[2][w] = cvtpk_s(p1[2 * w], p1[2 * w + 1]); pw[3][w] = cvtpk_s(p1[8 + 2 * w], p1[8 + 2 * w + 1]); } }
        }
        if (STAG) { if (kt + 2 < nkt) { ATT_WAIT_BAR(4); } else { ATT_WAIT_BAR(0); } }
        if (PV_F8 && kt <= mychunk && !(ABL == 2 || ABL == 8 || ABL == 9 || ABL == 11)) {
            asm volatile("s_nop 3" ::: );
#pragma unroll
            for (int db = 0; db < 4; ++db)
                asm volatile("v_mfma_scale_f32_32x32x64_f8f6f4 %0, %1, %2, %0, %3, %3 op_sel_hi:[0,0,0]" : "+v"(o[db]) : "v"(pa8), "v"(vb8[db]), "v"(0x7f7f7f7f));
        }
        if (!PV_F8 && kt <= mychunk) {
            const LAS char* vp = vbase + so_cur;
            constexpr int ND = (ABL == 2 || ABL == 8 || ABL == 9 || ABL == 11) ? 0 : 4;
            s16x4 vlo[2][4], vhi[2][4];
            if (ND) {
#pragma unroll
                for (int ks = 0; ks < 4; ++ks) { vlo[0][ks] = vtr(vp + ks * 1024); vhi[0][ks] = vtr(vp + ks * 1024 + 512); } }
#pragma unroll
            for (int d0 = 0; d0 < ND; ++d0) {
                if (d0 + 1 < ND) {
#pragma unroll
                    for (int ks = 0; ks < 4; ++ks) { vlo[(d0 + 1) & 1][ks] = vtr(vp + (d0 + 1) * 4096 + ks * 1024); vhi[(d0 + 1) & 1][ks] = vtr(vp + (d0 + 1) * 4096 + ks * 1024 + 512); } }
#pragma unroll
                for (int ks = 0; ks < 4; ++ks) { const s16x4 x = vlo[d0 & 1][ks], y = vhi[d0 & 1][ks]; const bf16x8 vf = (bf16x8){x[0], x[1], x[2], x[3], y[0], y[1], y[2], y[3]};
                    o[d0] = __builtin_amdgcn_mfma_f32_32x32x16_bf16(__builtin_bit_cast(bf16x8, pw[ks]), vf, o[d0], 0, 0, 0); }
            }
            if (ABL == 0) {
                __builtin_amdgcn_sched_group_barrier(0x100, 8, 0);
#pragma unroll
                for (int i = 0; i < 12; ++i) { __builtin_amdgcn_sched_group_barrier(0x8, 1, 0); __builtin_amdgcn_sched_group_barrier(0x100, 2, 0); }
                __builtin_amdgcn_sched_group_barrier(0x8, 4, 0); }
        }
        if (STAG) { so_cur = (so_cur + SLOT) & (4 * SLOT - 1); so_nn = (so_nn + SLOT) & (4 * SLOT - 1); }
        else { so_cur = (so_cur == 2 * SLOT) ? 0 : so_cur + SLOT; so_nn = (so_nn == 2 * SLOT) ? 0 : so_nn + SLOT; }
    }
    if (STAG && lagw == 0) { ATT_BAR_PLAIN(); }
    if (PV_F8) asm volatile("s_nop 15\n\ts_nop 15" ::: );
    { auto rr = __builtin_amdgcn_permlane32_swap(__float_as_uint(l), __float_as_uint(l), false, false); l = __uint_as_float(rr[0]) + __uint_as_float(rr[1]); }
    if (hi == 0) wsf[32 + r32] = l;
    asm volatile("s_waitcnt lgkmcnt(0)" ::: "memory");
    float rli[16];
#pragma unroll
    for (int r = 0; r < 16; ++r) rli[r] = 1.f / wsf[32 + crow(r, hi)];
#pragma unroll
    for (int d0 = 0; d0 < 4; ++d0)
#pragma unroll
        for (int r = 0; r < 16; ++r) o[d0][r] *= rli[r];
    ATT_WAIT_BAR(0);
    LAS float* EX = (LAS float*)L + rg * 4096;
    if (map == 1) {
#pragma unroll
        for (int d0 = 0; d0 < 4; ++d0)
#pragma unroll
            for (int r = 0; r < 16; ++r) EX[(d0 * 16 + r) * 64 + lane] = o[d0][r]; }
    ATT_WAIT_BAR(0);
    if (map == 0) {
        float ss[16];
#pragma unroll
        for (int r = 0; r < 16; ++r) ss[r] = 0.f;
#pragma unroll
        for (int d0 = 0; d0 < 4; ++d0)
#pragma unroll
            for (int r = 0; r < 16; ++r) { const float x = o[d0][r] - lam * EX[(d0 * 16 + r) * 64 + lane]; o[d0][r] = x; ss[r] += x * x; }
#pragma unroll
        for (int r = 0; r < 16; ++r) { float s = ss[r]; s += __shfl_xor(s, 1); s += __shfl_xor(s, 2); s += __shfl_xor(s, 4); s += __shfl_xor(s, 8); s += __shfl_xor(s, 16); ss[r] = rsqrtf(s * (1.f / 128.f) + EPS) * 0.8f; }
        bf16* OA = WSP(bf16, WS_OA);
#pragma unroll
        for (int d0 = 0; d0 < 4; ++d0) { const float g = a.in[9][32 * d0 + r32];
#pragma unroll
            for (int r = 0; r < 16; ++r) OA[(size_t)(q0w + crow(r, hi)) * 512 + h * 128 + 32 * d0 + r32] = (bf16)f2bf(o[d0][r] * ss[r] * g); }
    }
    ATT_WAIT_BAR(0);
#undef ATT_DMA
}

template <int THRL, int AB3 = 0>
__device__ __forceinline__ void attn_unit3(const Args& a, LAS unsigned char* L, int h, int qt, float lam) {
    const int tid = threadIdx.x, lane = tid & 63, r32 = lane & 31, hi = lane >> 5;
    const int wid = __builtin_amdgcn_readfirstlane(tid >> 6), rg = wid & 3, map = wid >> 2;
    const bf16* PROJ = WSP(const bf16, WS_PROJ);
    const int q0w = qt * 128 + rg * 32, mychunk = 2 * qt + (rg >> 1), nkt = 2 * qt + 2;
    const unsigned lds0 = (unsigned)(uintptr_t)L;
    LAS float* wsf = (LAS float*)(L + LDS_WS) + wid * 64;
    const LAS float* TAB = (const LAS float*)(L + TAB_OFF);
    const float farb2 = TAB[1280 + h];
    const int krow = 8 * wid + (lane >> 3);
    const bf16* ksrc0 = PROJ + (size_t)krow * NPROJ + PC_KA + h * 128 + (((lane & 7) ^ ((krow >> 1) & 7)) * 8);
    const unsigned char* vsrc8 = (const unsigned char*)a.ws + WS_VIMG + (size_t)h * 256 * 8192 + wid * 1024 + lane * 16;
    const unsigned kdst = lds0 + OFF_K + wid * 1024, vdst = lds0 + OFF_V + wid * 1024;
#define ATT_DMA(t, so) do { const size_t ro_ = (size_t)(t) * 64 * NPROJ; \
        glds16(ksrc0 + ro_, (unsigned)__builtin_amdgcn_readfirstlane(kdst + (so))); glds16(ksrc0 + ro_ + 64, (unsigned)__builtin_amdgcn_readfirstlane(kdst + (so) + 8192)); \
        glds16(vsrc8 + (size_t)(t) * 8192, (unsigned)__builtin_amdgcn_readfirstlane(vdst + (so))); } while (0)
    constexpr float PO = 8.f, THRF = 0.5f;
    constexpr bool NO_SM = (AB3 == 1 || AB3 == 7 || AB3 >= 9), NO_MMA = (AB3 == 2 || AB3 == 8 || AB3 >= 9), NO_RD = (AB3 == 4 || AB3 == 12), NO_B = (AB3 >= 6), NO_A = (AB3 == 5), NO_DMA = (AB3 == 10), NO_BAR = (AB3 == 11);
    asm volatile("s_waitcnt vmcnt(0)" ::: "memory");
    ATT_DMA(0, 0); ATT_DMA(1, SLOT);
    bf16x8 qr[4];
    { const bf16* Qw = PROJ + (size_t)(q0w + r32) * NPROJ + PC_QA + h * 128 + map * 64 + hi * 8;
#pragma unroll
      for (int d0 = 0; d0 < 4; ++d0) qr[d0] = *reinterpret_cast<const bf16x8*>(Qw + d0 * 16); }
    asm volatile("" : "+v"(qr[0]), "+v"(qr[1]), "+v"(qr[2]), "+v"(qr[3]));
    float mhat = 0.f, l = 0.f;
    f32x16 o[4];
#pragma unroll
    for (int d0 = 0; d0 < 4; ++d0) o[d0] = f32x16{};
    f32x16 cinF, p0, p1;
#pragma unroll
    for (int r = 0; r < 16; ++r) { cinF[r] = farb2; p0[r] = 0.f; p1[r] = 0.f; }
    int so_cur = 0, so_nn = 2 * SLOT;
    const LAS char* kbase = (const LAS char*)L + OFF_K + map * 8192 + r32 * 128;
    int koff[4];
#pragma unroll
    for (int j = 0; j < 4; ++j) koff[j] = (((2 * j + hi) ^ ((r32 >> 1) & 7)) * 16);
    const LAS char* vbase8 = (const LAS char*)L + OFF_V + (lane >> 5) * 256 + ((lane & 15) >> 1) * 32 + ((lane >> 4) & 1) * 16 + (lane & 1) * 8;
    pg8::i32x8_ pa8, vb8[4];
#pragma unroll
    for (int g = 0; g < 8; ++g) { pa8[g] = 0; vb8[0][g] = 0; vb8[1][g] = 0; vb8[2][g] = 0; vb8[3][g] = 0; }
    bool pend = false;
#define ATT_QK(so) do { const LAS char* kp_ = kbase + (so); bf16x8 kf[8]; \
        _Pragma("unroll") for (int j = 0; j < (NO_RD ? 0 : 4); ++j) { kf[2 * j] = *(const LAS bf16x8*)(kp_ + koff[j]); kf[2 * j + 1] = *(const LAS bf16x8*)(kp_ + koff[j] + 4096); } \
        asm volatile("" : "+v"(kf[0]), "+v"(kf[1]), "+v"(kf[2]), "+v"(kf[3]), "+v"(kf[4]), "+v"(kf[5]), "+v"(kf[6]), "+v"(kf[7])); \
        const f32x16 cin_ = cinF; if (NO_MMA) { p0 = cin_; p1 = cin_; break; } \
        p0 = __builtin_amdgcn_mfma_f32_32x32x16_bf16(kf[0], qr[0], cin_, 0, 0, 0); p1 = __builtin_amdgcn_mfma_f32_32x32x16_bf16(kf[1], qr[0], cin_, 0, 0, 0); \
        _Pragma("unroll") for (int d0 = 1; d0 < 4; ++d0) { p0 = __builtin_amdgcn_mfma_f32_32x32x16_bf16(kf[2 * d0], qr[d0], p0, 0, 0, 0); p1 = __builtin_amdgcn_mfma_f32_32x32x16_bf16(kf[2 * d0 + 1], qr[d0], p1, 0, 0, 0); } } while (0)
#define ATT_VREADS(so) do { if (NO_RD) break; const LAS char* vp_ = vbase8 + (so); \
        _Pragma("unroll") for (int db = 0; db < 4; ++db) _Pragma("unroll") for (int j = 0; j < 4; ++j) { const v2i32_t t_ = vtr8(vp_ + db * 2048 + j * 512); vb8[db][2 * j] = t_[0]; vb8[db][2 * j + 1] = t_[1]; } } while (0)
#define ATT_PV() do { if (NO_MMA) break; asm volatile("s_nop 3" ::: ); \
        _Pragma("unroll") for (int db = 0; db < 4; ++db) asm volatile("v_mfma_scale_f32_32x32x64_f8f6f4 %0, %1, %2, %0, %3, %3 op_sel_hi:[0,0,0]" : "+v"(o[db]) : "v"(pa8), "v"(vb8[db]), "v"(0x7f7f7f7f)); } while (0)
#define ATT_SM(kt_) do { if (NO_SM) { _Pragma("unroll") for (int g = 0; g < 4; ++g) { pa8[g] = pk4_fp8a(p0[4 * g], p0[4 * g + 1], p0[4 * g + 2], p0[4 * g + 3]); pa8[4 + g] = pk4_fp8a(p1[4 * g], p1[4 * g + 1], p1[4 * g + 2], p1[4 * g + 3]); } break; } \
        if (!((kt_) * 64 + 63 - q0w <= -128)) { const LAS float* tb = TAB + h * 320 + 255 + (kt_) * 64 - (q0w + r32) + 4 * hi; \
            _Pragma("unroll") for (int r = 0; r < 16; ++r) { p0[r] += tb[(r & 3) + 8 * (r >> 2)]; p1[r] += tb[32 + (r & 3) + 8 * (r >> 2)]; } } \
        float sacc = 0.f; bool resc = false; \
        float rma = max3f(p0[0], p0[1], p1[0]), rmb = max3f(p0[2], p0[3], p1[1]); rma = max3f(rma, p1[2], p1[3]); \
        _Pragma("unroll") for (int r = 4; r < 16; r += 4) { rma = max3f(rma, p0[r], p0[r + 1]); rmb = max3f(rmb, p0[r + 2], p0[r + 3]); rma = max3f(rma, p1[r], p1[r + 1]); rmb = max3f(rmb, p1[r + 2], p1[r + 3]); } \
        float rm = max3f(rma, rmb, rmb); \
        { auto rr = __builtin_amdgcn_permlane32_swap(__float_as_uint(rm), __float_as_uint(rm), false, false); rm = max3f(__uint_as_float(rr[0]), __uint_as_float(rr[1]), __uint_as_float(rr[1])); } \
        if ((kt_) == 0 || __any(rm > THRF + PO)) { \
            const float dl = ((kt_) == 0) ? rm - PO : fmaxf(rm - PO, 0.f); mhat += dl; \
            _Pragma("unroll") for (int r = 0; r < 16; ++r) { p0[r] -= dl; p1[r] -= dl; } \
            const float f = __builtin_amdgcn_exp2f(-dl); l *= f; if (hi == 0) wsf[r32] = f; resc = ((kt_) != 0); \
            _Pragma("unroll") for (int r = 0; r < 16; ++r) cinF[r] = farb2 - mhat; } \
        _Pragma("unroll") for (int r = 0; r < 16; ++r) { p0[r] = __builtin_amdgcn_exp2f(p0[r]); p1[r] = __builtin_amdgcn_exp2f(p1[r]); sacc += p0[r] + p1[r]; } \
        l += sacc; \
        if (resc) { asm volatile("s_waitcnt lgkmcnt(0)" ::: "memory"); \
            _Pragma("unroll") for (int r = 0; r < 16; ++r) { const float f = wsf[crow(r, hi)]; _Pragma("unroll") for (int d0 = 0; d0 < 4; ++d0) o[d0][r] *= f; } } \
        _Pragma("unroll") for (int g = 0; g < 4; ++g) { pa8[g] = pk4_fp8a(p0[4 * g], p0[4 * g + 1], p0[4 * g + 2], p0[4 * g + 3]); pa8[4 + g] = pk4_fp8a(p1[4 * g], p1[4 * g + 1], p1[4 * g + 2], p1[4 * g + 3]); } } while (0)
    if (map == ATT_AHALF) {
        if (ATT_PRIO) asm volatile("s_setprio 1" ::: );
        for (int kt = 0; kt < nkt; ++kt) {
            if (NO_BAR) { asm volatile("s_waitcnt vmcnt(0) lgkmcnt(0)" ::: "memory"); } else { ATT_WAIT_BAR(0); }
            if (!NO_DMA && kt + 2 < nkt) ATT_DMA(kt + 2, so_nn);
            const int so_nx = (so_cur == 2 * SLOT) ? 0 : so_cur + SLOT;
            if (!NO_A) { if (kt == 0) ATT_QK(so_cur);
            if (kt <= mychunk) { ATT_VREADS(so_cur); ATT_SM(kt); ATT_PV(); }
            if (kt + 1 <= mychunk) ATT_QK(so_nx); }
            so_cur = so_nx; so_nn = (so_nn == 2 * SLOT) ? 0 : so_nn + SLOT;
        }
        if (ATT_PRIO) asm volatile("s_setprio 0" ::: );
    } else {
        for (int kt = 0; kt < nkt; ++kt) {
            if (NO_BAR) { asm volatile("s_waitcnt vmcnt(0) lgkmcnt(0)" ::: "memory"); } else { ATT_WAIT_BAR(0); }
            if (!NO_DMA && kt + 2 < nkt) ATT_DMA(kt + 2, so_nn);
            if (!NO_B) { if (pend) { ATT_PV(); pend = false; }
            if (kt <= mychunk) { ATT_VREADS(so_cur); ATT_QK(so_cur); ATT_SM(kt); pend = true; } }
            so_cur = (so_cur == 2 * SLOT) ? 0 : so_cur + SLOT; so_nn = (so_nn == 2 * SLOT) ? 0 : so_nn + SLOT;
        }
        if (pend) ATT_PV();
    }
    { bf16x8 z_ = {0, 0, 0, 0, 0, 0, 0, 0}; asm volatile("" : "+v"(z_));
      asm volatile("s_nop 3\n\tv_mfma_f32_32x32x16_bf16 %0, %1, %2, %0\n\ts_nop 15\n\ts_nop 15" : "+v"(o[3]) : "v"(z_), "v"(qr[0])); }
#undef ATT_QK
#undef ATT_VREADS
#undef ATT_PV
#undef ATT_SM
    int lane_e = lane; asm volatile("" : "+v"(lane_e));
    const int r32e = lane_e & 31, hie = lane_e >> 5;
    { auto rr = __builtin_amdgcn_permlane32_swap(__float_as_uint(l), __float_as_uint(l), false, false); l = __uint_as_float(rr[0]) + __uint_as_float(rr[1]); }
    if (hie == 0) wsf[32 + r32e] = l;
    asm volatile("s_waitcnt lgkmcnt(0)" ::: "memory");
    float rli[16];
#pragma unroll
    for (int r = 0; r < 16; ++r) rli[r] = 1.f / wsf[32 + crow(r, hie)];
#pragma unroll
    for (int d0 = 0; d0 < 4; ++d0)
#pragma unroll
        for (int r = 0; r < 16; ++r) o[d0][r] *= rli[r];
    ATT_WAIT_BAR(0);
    LAS float* EX = (LAS float*)L + rg * 4096;
    if (map == 1) {
#pragma unroll
        for (int d0 = 0; d0 < 4; ++d0)
#pragma unroll
            for (int r = 0; r < 16; ++r) EX[(d0 * 16 + r) * 64 + lane_e] = o[d0][r]; }
    ATT_WAIT_BAR(0);
    if (map == 0) {
        float ss[16];
#pragma unroll
        for (int r = 0; r < 16; ++r) ss[r] = 0.f;
#pragma unroll
        for (int d0 = 0; d0 < 4; ++d0)
#pragma unroll
            for (int r = 0; r < 16; ++r) { const float x = o[d0][r] - lam * EX[(d0 * 16 + r) * 64 + lane_e]; o[d0][r] = x; ss[r] += x * x; }
#pragma unroll
        for (int r = 0; r < 16; ++r) { float s = ss[r]; s += __shfl_xor(s, 1); s += __shfl_xor(s, 2); s += __shfl_xor(s, 4); s += __shfl_xor(s, 8); s += __shfl_xor(s, 16); ss[r] = rsqrtf(s * (1.f / 128.f) + EPS) * 0.8f; }
        bf16* OA = WSP(bf16, WS_OA);
#pragma unroll
        for (int d0 = 0; d0 < 4; ++d0) { const float g = a.in[9][32 * d0 + r32e];
#pragma unroll
            for (int r = 0; r < 16; ++r) OA[(size_t)(q0w + crow(r, hie)) * 512 + h * 128 + 32 * d0 + r32e] = (bf16)f2bf(o[d0][r] * ss[r] * g); }
    }
    ATT_WAIT_BAR(0);
#undef ATT_DMA
}
struct OneUnit { int pn; __device__ __forceinline__ bool next(int i, pg8::Unit& u) const { if (i > 0) return false; u.pm = 0; u.pn = pn; return true; }
    __device__ __forceinline__ void a_ready(const pg8::Unit&) const {} __device__ __forceinline__ void done(const pg8::Unit&) const {} };
constexpr int CW_Q = 3000;
#ifndef ATT_STAG
#define ATT_STAG false
#endif
template <int ABL = 0>
__device__ __forceinline__ void attn_queue(const Args& a, LAS unsigned char* L, int tid, int qword = 0) {
    float s1 = 0.f, s2 = 0.f;
    for (int i = 0; i < 64; ++i) { s1 += a.in[5][i] * a.in[6][i]; s2 += a.in[7][i] * a.in[8][i]; }
    const float lam = expf(s1) - expf(s2) + 0.2f;
    volatile LAS int* qslot = (volatile LAS int*)(L + MISC_OFF + 64);
    gu32* qh = (gu32*)(a.ws + WS_CTL) + CW_Q + qword;
    for (;;) {
        if (tid == 0) *qslot = (int)__hip_atomic_fetch_add(qh, 1u, RLX_AGENT);
        __syncthreads();
        const int idx = *qslot;
        if (idx >= 512) break;
        if (PV_F8 && ABL >= 20) attn_unit3<8, ABL - 20>(a, L, idx & 3, 127 - (idx >> 2), lam); else if (PV_F8 && ABL == 0 && ATT_COMPL) attn_unit3<8>(a, L, idx & 3, 127 - (idx >> 2), lam); else attn_unit<8, ABL, ATT_STAG>(a, L, idx & 3, 127 - (idx >> 2), lam);
    }
}
}

namespace gdn {
using bf16x8 = __attribute__((ext_vector_type(8))) short;
using f32x4v = __attribute__((ext_vector_type(4))) float;
using u32x4v = __attribute__((ext_vector_type(4))) unsigned;
using u32x2v = __attribute__((ext_vector_type(2))) unsigned;
constexpr int ROWB = 272;
constexpr int HALF_BYTES = 65536, OFF_KN = 0, OFF_QN = 17408, OFF_VN = 34816, OFF_SM = 52224;
constexpr size_t GA_UNIT = 57344, GU_UNIT = 16384;
constexpr int GA_W = 0, GA_QD = 16384, GA_KDT = 32768, GA_QK = 49152;
constexpr size_t WS_GA = 692 * MiB, WS_GU = 748 * MiB, WS_GL = 690 * MiB + 768 * 1024;
constexpr int SBUF = 65536;
__device__ __forceinline__ unsigned cvtpk(float lo, float hi) { typedef float f2 __attribute__((ext_vector_type(2))); typedef __bf16 b2 __attribute__((ext_vector_type(2))); f2 v = {lo, hi}; b2 b = __builtin_convertvector(v, b2); return __builtin_bit_cast(unsigned, b); }
__device__ __forceinline__ f32x4v mfma16(bf16x8 a, bf16x8 b, f32x4v c) { return __builtin_amdgcn_mfma_f32_16x16x32_bf16(a, b, c, 0, 0, 0); }

__device__ __forceinline__ void chunk_units(const Args& a, LAS unsigned char* L, int tid, int G, int bid) {
    const int half = tid >> 8, th = tid & 255, lane = tid & 63, hw = (tid >> 6) & 3, quad = lane >> 4, l15 = lane & 15;
    LAS unsigned char* B = L + half * HALF_BYTES;
    LAS unsigned char* KN = B + OFF_KN; LAS unsigned char* QN = B + OFF_QN; LAS unsigned char* VN = B + OFF_VN;
    LAS float* SMgc = (LAS float*)(B + OFF_SM); LAS float* SMeg = SMgc + 64; LAS float* SMekl = SMgc + 128; LAS float* SMbeta = SMgc + 192;
    LAS float* Lm = (LAS float*)QN;
    const bf16* PROJ = WSP(const bf16, WS_PROJ); const float* cw = a.in[10];
    for (int base = bid * 2; base < 1024; base += G * 2) {
        int u = base + half; if (u > 1023) u = 1023;
        const int h = u >> 8, n = u & 255, t0 = n * 64;
        unsigned char* GAu = a.ws + WS_GA + (size_t)u * GA_UNIT; unsigned char* GUu = a.ws + WS_GU + (size_t)u * GU_UNIT;
        __syncthreads();
#ifndef NO_CONV
        { const int cg = th & 15, rq = th >> 4;
#pragma unroll
          for (int p = 0; p < 3; ++p) {
              float w[4][8];
#pragma unroll
              for (int j = 0; j < 4; ++j) { const f32x4v w0 = *(const f32x4v*)(cw + j * 1536 + 512 * p + h * 128 + 8 * cg), w1 = *(const f32x4v*)(cw + j * 1536 + 512 * p + h * 128 + 8 * cg + 4);
                  w[j][0] = w0[0]; w[j][1] = w0[1]; w[j][2] = w0[2]; w[j][3] = w0[3]; w[j][4] = w1[0]; w[j][5] = w1[1]; w[j][6] = w1[2]; w[j][7] = w1[3]; }
              float in[7][8];
#pragma unroll
              for (int m = 0; m < 7; ++m) { const int tt = t0 + 4 * rq - 3 + m; u32x4v raw = {0u, 0u, 0u, 0u};
                  if (tt >= 0) raw = *(const u32x4v*)(PROJ + (size_t)tt * NPROJ + PC_QB + 512 * p + h * 128 + 8 * cg);
#pragma unroll
                  for (int i = 0; i < 4; ++i) { in[m][2 * i] = bflo(raw[i]); in[m][2 * i + 1] = bfhi(raw[i]); } }
              LAS unsigned char* T = (p == 0) ? QN : (p == 1) ? KN : VN;
#pragma unroll
              for (int r = 0; r < 4; ++r) { float y[8]; float ss = 0.f;
#pragma unroll
                  for (int i = 0; i < 8; ++i) { float acc = 0.f;
#pragma unroll
                      for (int j = 0; j < 4; ++j) acc += w[j][i] * in[r + j][i];
                      y[i] = siluf_(acc); ss += y[i] * y[i]; }
                  if (p < 2) { ss += __shfl_xor(ss, 1); ss += __shfl_xor(ss, 2); ss += __shfl_xor(ss, 4); ss += __shfl_xor(ss, 8);
                      const float rn = rsqrtf(ss + EPS) * (p == 0 ? 0.08838834764831845f : 1.f);
#pragma unroll
                      for (int i = 0; i < 8; ++i) y[i] *= rn; }
                  u32x4v o; o[0] = cvtpk(y[0], y[1]); o[1] = cvtpk(y[2], y[3]); o[2] = cvtpk(y[4], y[5]); o[3] = cvtpk(y[6], y[7]);
                  *(LAS u32x4v*)(T + (4 * rq + r) * ROWB + cg * 16) = o; }
          } }
#endif
        if (hw == 0) { float gi = WSP(const float, WS_GG)[(size_t)(t0 + lane) * 4 + h]; const float be = WSP(const float, WS_GBETA)[(size_t)(t0 + lane) * 4 + h];
#pragma unroll
            for (int o = 1; o < 64; o <<= 1) { const float t = __shfl_up(gi, o); if (lane >= o) gi += t; }
            const float glast = __shfl(gi, 63);
            SMgc[lane] = gi; SMeg[lane] = expf(gi); SMekl[lane] = expf(glast - gi); SMbeta[lane] = be;
            if (lane == 0) ((float*)(a.ws + WS_GL))[u] = expf(glast); }
        __syncthreads();
#pragma unroll
        for (int m = 0; m < 4; ++m) { const int c = hw + 4 * m, ti = c >> 2, kk = c & 3, i = 16 * ti + l15, da = 32 * kk + 4 * quad;
            const u32x2v ra = *(const LAS u32x2v*)(QN + i * ROWB + da * 2), rb = *(const LAS u32x2v*)(QN + i * ROWB + (da + 16) * 2); const float e = SMeg[i];
            u32x4v o; o[0] = cvtpk(bflo(ra[0]) * e, bfhi(ra[0]) * e); o[1] = cvtpk(bflo(ra[1]) * e, bfhi(ra[1]) * e); o[2] = cvtpk(bflo(rb[0]) * e, bfhi(rb[0]) * e); o[3] = cvtpk(bflo(rb[1]) * e, bfhi(rb[1]) * e);
            *(u32x4v*)(GAu + GA_QD + (c * 64 + lane) * 16) = o; }
        { const int ti = hw, i = 16 * ti + l15; const float gci = SMgc[i];
          unsigned pk[4][2];
#pragma unroll
          for (int tj = 0; tj < 4; ++tj) { f32x4v acc = {0.f, 0.f, 0.f, 0.f};
#pragma unroll
              for (int kk = 0; kk < 4; ++kk) { const bf16x8 af = *(const LAS bf16x8*)(KN + (16 * tj + l15) * ROWB + (32 * kk + 8 * quad) * 2), bfr = *(const LAS bf16x8*)(QN + i * ROWB + (32 * kk + 8 * quad) * 2);
                  acc = mfma16(af, bfr, acc); }
              float vv[4];
#pragma unroll
              for (int r = 0; r < 4; ++r) { const int j = 16 * tj + 4 * quad + r; vv[r] = (j <= i) ? acc[r] * __expf(gci - SMgc[j]) : 0.f; }
              pk[tj][0] = cvtpk(vv[0], vv[1]); pk[tj][1] = cvtpk(vv[2], vv[3]); }
#pragma unroll
          for (int kj = 0; kj < 2; ++kj) { u32x4v o; o[0] = pk[2 * kj][0]; o[1] = pk[2 * kj][1]; o[2] = pk[2 * kj + 1][0]; o[3] = pk[2 * kj + 1][1];
              *(u32x4v*)(GAu + GA_QK + ((ti * 2 + kj) * 64 + lane) * 16) = o; } }
#pragma unroll
        for (int m = 0; m < 4; ++m) { const int c = hw + 4 * m, td = c >> 1, kj = c & 1, d = 16 * td + l15; float vv[8];
#pragma unroll
            for (int jj = 0; jj < 8; ++jj) { const int j = 32 * kj + 16 * (jj >> 2) + 4 * quad + (jj & 3); vv[jj] = bf2f(*(const LAS bf16*)(KN + j * ROWB + d * 2)) * SMekl[j]; }
            u32x4v o; o[0] = cvtpk(vv[0], vv[1]); o[1] = cvtpk(vv[2], vv[3]); o[2] = cvtpk(vv[4], vv[5]); o[3] = cvtpk(vv[6], vv[7]);
            *(u32x4v*)(GAu + GA_KDT + (c * 64 + lane) * 16) = o; }
        __syncthreads();
        { const int ti = hw;
#pragma unroll
          for (int tj = 0; tj < 4; ++tj) { if (tj <= ti) { f32x4v acc = {0.f, 0.f, 0.f, 0.f};
#pragma unroll
              for (int kk = 0; kk < 4; ++kk) { const bf16x8 af = *(const LAS bf16x8*)(KN + (16 * ti + l15) * ROWB + (32 * kk + 8 * quad) * 2), bfr = *(const LAS bf16x8*)(KN + (16 * tj + l15) * ROWB + (32 * kk + 8 * quad) * 2);
                  acc = mfma16(af, bfr, acc); }
              const int j = 16 * tj + l15; const float gcj = SMgc[j];
#pragma unroll
              for (int r = 0; r < 4; ++r) { const int i = 16 * ti + 4 * quad + r; Lm[i * 64 + j] = (i > j) ? SMbeta[i] * acc[r] * __expf(SMgc[i] - gcj) : 0.f; } } } }
        __syncthreads();
        float x[64];
#pragma unroll
        for (int i = 0; i < 64; ++i) x[i] = 0.f;
#ifndef NO_SOLVE
        { const bool isw = th >= 128; const LAS unsigned char* T = (isw ? KN : VN) + (th & 127) * 2;
#pragma unroll
          for (int i = 0; i < 64; ++i) { const float egi = SMeg[i]; const float sc = SMbeta[i] * (isw ? egi : 1.f);
              float acc = bf2f(*(const LAS bf16*)(T + i * ROWB)) * sc;
#pragma unroll
              for (int j4 = 0; j4 < (i + 3) / 4; ++j4) { const f32x4v l4 = *(const LAS f32x4v*)(Lm + i * 64 + 4 * j4);
                  acc -= l4[0] * x[4 * j4]; acc -= l4[1] * x[4 * j4 + 1]; acc -= l4[2] * x[4 * j4 + 2]; acc -= l4[3] * x[4 * j4 + 3]; if ((j4 & 3) == 3) asm volatile("" ::: "memory"); }
              asm volatile("" : "+v"(acc) :: "memory"); x[i] = acc; } }
#endif
        if (th < 128) { const int s = th >> 4, e = th & 15;
#pragma unroll
            for (int i4 = 0; i4 < 16; ++i4) { const int ti = i4 >> 2, q4 = i4 & 3; u32x2v o; o[0] = cvtpk(x[4 * i4], x[4 * i4 + 1]); o[1] = cvtpk(x[4 * i4 + 2], x[4 * i4 + 3]);
                *(u32x2v*)(GUu + (size_t)(((s * 4 + ti) * 64 + q4 * 16 + e) * 8)) = o; } }
        __syncthreads();
        if (th >= 128) { const int d = th - 128, kk = d >> 5, dp = d & 31, q4 = (dp >> 2) & 3, jj = 4 * (dp >> 4) + (dp & 3);
#pragma unroll
            for (int i = 0; i < 64; ++i) *(LAS bf16*)(KN + (((i >> 4) * 4 + kk) * 64 + q4 * 16 + (i & 15)) * 16 + jj * 2) = (bf16)f2bf(x[i]); }
        __syncthreads();
#pragma unroll
        for (int m = 0; m < 4; ++m) { const int off = (m * 256 + th) * 16; *(u32x4v*)(GAu + GA_W + off) = *(const LAS u32x4v*)(KN + off); }
    }
}

#define GDN_BAR_LDS() asm volatile("s_waitcnt lgkmcnt(0)\n\ts_barrier" ::: "memory")
#define GDN_BAR_ALL() asm volatile("s_waitcnt vmcnt(0) lgkmcnt(0)\n\ts_barrier" ::: "memory")
template <int MODE = 0>
__device__ __forceinline__ void scan_wg(const Args& a, LAS unsigned char* L, int tid, int h, int half) {
    const int lane = tid & 63, wid = __builtin_amdgcn_readfirstlane(tid >> 6), quad = lane >> 4, l15 = lane & 15;
    const unsigned lds0 = (unsigned)(uintptr_t)L;
    const unsigned char* GAh = a.ws + WS_GA + (size_t)h * 256 * GA_UNIT; const unsigned char* GUh = a.ws + WS_GU + (size_t)h * 256 * GU_UNIT + (size_t)half * 8192;
    const float* GLh = (const float*)(a.ws + WS_GL) + h * 256; bf16* GO = (bf16*)(a.ws + WS_GO);
    LAS float* GLl = (LAS float*)(L + MISC_OFF + 1024);
    if (tid < 256) GLl[tid] = GLh[tid];
    __syncthreads();
    if (wid >= 4) {
#define GDN_LOAD(n, bo) do { for (int p = wid - 4; p < 64; p += 4) { const unsigned char* src = (p < 56) ? GAh + (size_t)(n) * GA_UNIT + p * 1024 + lane * 16 : GUh + (size_t)(n) * GU_UNIT + (p - 56) * 1024 + lane * 16; \
            att::glds16(src, (unsigned)__builtin_amdgcn_readfirstlane(lds0 + (bo) + p * 1024)); } } while (0)
#define GDN_LD(R, n) do { const int n_ = (n) < 256 ? (n) : 255; _Pragma("unroll") for (int m = 0; m < 16; ++m) { const int p = wid - 4 + 4 * m; \
            R[m] = *(const u32x4v*)((p < 56) ? GAh + (size_t)n_ * GA_UNIT + p * 1024 + lane * 16 : GUh + (size_t)n_ * GU_UNIT + (p - 56) * 1024 + lane * 16); } } while (0)
#define GDN_ST(R, bo) do { _Pragma("unroll") for (int m = 0; m < 16; ++m) { const int p = wid - 4 + 4 * m; *(LAS u32x4v*)(L + (bo) + p * 1024 + lane * 16) = R[m]; } } while (0)
#define GDN_DRAIN(c, bo) do { _Pragma("unroll") for (int m = 0; m < 2; ++m) { const int j = (wid - 4) + 4 * m, ch = j >> 1, r = 32 * (j & 1) + (lane >> 1); \
            const u32x4v v = *(const LAS u32x4v*)(L + (bo) + 57344 + j * 1024 + lane * 16); \
            *(u32x4v*)(GO + (size_t)((c) * 64 + r) * 512 + h * 128 + half * 64 + ch * 16 + (lane & 1) * 8) = v; } } while (0)
        u32x4v X[16], Y[16], Z[16];
        GDN_LD(X, 0); GDN_ST(X, 0); GDN_LD(Y, 1); GDN_LD(Z, 2); GDN_LD(X, 3);
#define GDN_STEP(n, R) do { GDN_BAR_LDS(); if (MODE != 1) { if ((n) > 0 && (n) <= 256) GDN_DRAIN((n) - 1, (((n) + 1) & 1) * SBUF); GDN_ST(R, (((n) + 1) & 1) * SBUF); GDN_LD(R, (n) + 4); } } while (0)
        for (int n = 0; n < 258; n += 6) { GDN_STEP(n, Y); GDN_STEP(n + 1, Z); GDN_STEP(n + 2, X); GDN_STEP(n + 3, Y); GDN_STEP(n + 4, Z); GDN_STEP(n + 5, X); }
        GDN_BAR_LDS();
#undef GDN_STEP
#undef GDN_DRAIN
#undef GDN_LD
#undef GDN_ST
#undef GDN_LOAD
    } else {
        const int s = half * 4 + wid;
        f32x4v S[8]; bf16x8 Sb[4];
#pragma unroll
        for (int td = 0; td < 8; ++td) S[td] = (f32x4v){0.f, 0.f, 0.f, 0.f};
#pragma unroll
        for (int kk = 0; kk < 4; ++kk) Sb[kk] = (bf16x8){0, 0, 0, 0, 0, 0, 0, 0};
        for (int n = 0; n < 258; ++n) {
            GDN_BAR_LDS();
            if (MODE == 2 || n >= 256) continue;
            const float gl = GLl[n];
            const LAS unsigned char* Bf = L + (n & 1) * SBUF + lane * 16;
            const LAS unsigned char* Uf = L + (n & 1) * SBUF + 57344 + wid * 2048 + lane * 8;
            f32x4v W[4], O[4];
#pragma unroll
            for (int ti = 0; ti < 4; ++ti) { W[ti] = (f32x4v){0.f, 0.f, 0.f, 0.f}; O[ti] = (f32x4v){0.f, 0.f, 0.f, 0.f}; }
#pragma unroll
            for (int ti = 0; ti < 4; ++ti)
#pragma unroll
                for (int kk = 0; kk < 4; ++kk) W[ti] = mfma16(*(const LAS bf16x8*)(Bf + GA_W + (ti * 4 + kk) * 1024), Sb[kk], W[ti]);
#pragma unroll
            for (int ti = 0; ti < 4; ++ti)
#pragma unroll
                for (int kk = 0; kk < 4; ++kk) O[ti] = mfma16(Sb[kk], *(const LAS bf16x8*)(Bf + GA_QD + (ti * 4 + kk) * 1024), O[ti]);
            f32x4v vn[4];
#pragma unroll
            for (int ti = 0; ti < 4; ++ti) { const u32x2v ur = *(const LAS u32x2v*)(Uf + ti * 512); vn[ti] = (f32x4v){bflo(ur[0]), bfhi(ur[0]), bflo(ur[1]), bfhi(ur[1])} - W[ti]; }
            bf16x8 vnb[2];
#pragma unroll
            for (int kj = 0; kj < 2; ++kj) { u32x4v t; t[0] = cvtpk(vn[2 * kj][0], vn[2 * kj][1]); t[1] = cvtpk(vn[2 * kj][2], vn[2 * kj][3]); t[2] = cvtpk(vn[2 * kj + 1][0], vn[2 * kj + 1][1]); t[3] = cvtpk(vn[2 * kj + 1][2], vn[2 * kj + 1][3]);
                vnb[kj] = __builtin_bit_cast(bf16x8, t); }
#pragma unroll
            for (int td = 0; td < 8; ++td) { S[td] = S[td] * gl;
#pragma unroll
                for (int kj = 0; kj < 2; ++kj) S[td] = mfma16(*(const LAS bf16x8*)(Bf + GA_KDT + (td * 2 + kj) * 1024), vnb[kj], S[td]); }
#pragma unroll
            for (int ti = 0; ti < 4; ++ti)
#pragma unroll
                for (int kj = 0; kj < 2; ++kj) O[ti] = mfma16(vnb[kj], *(const LAS bf16x8*)(Bf + GA_QK + (ti * 2 + kj) * 1024), O[ti]);
#pragma unroll
            for (int kk = 0; kk < 4; ++kk) { u32x4v t; t[0] = cvtpk(S[2 * kk][0], S[2 * kk][1]); t[1] = cvtpk(S[2 * kk][2], S[2 * kk][3]); t[2] = cvtpk(S[2 * kk + 1][0], S[2 * kk + 1][1]); t[3] = cvtpk(S[2 * kk + 1][2], S[2 * kk + 1][3]);
                Sb[kk] = __builtin_bit_cast(bf16x8, t); }
#pragma unroll
            for (int ti = 0; ti < 4; ++ti) { u32x2v o2; o2[0] = cvtpk(O[ti][0], O[ti][1]); o2[1] = cvtpk(O[ti][2], O[ti][3]);
                *(LAS u32x2v*)(L + (n & 1) * SBUF + 57344 + wid * 2048 + (16 * ti + l15) * 32 + quad * 8) = o2; }
        }
        GDN_BAR_LDS();
    }
    asm volatile("s_waitcnt vmcnt(0) lgkmcnt(0)" ::: "memory");
}
}

namespace xat {
using bf16x8 = gdn::bf16x8; using f32x4v = gdn::f32x4v; using u32x4v = gdn::u32x4v; using u32x2v = gdn::u32x2v;
constexpr int SLOT = 32768;
constexpr float CS = 0.0625f * 1.4426950408889634f;
__device__ __forceinline__ void dma_tile(const bf16* KVX, int hh, int ft, unsigned dst, int wid, int lane) {
    if (ft < 4) {
#pragma unroll
        for (int i = 0; i < 4; ++i) { const int c = wid + 8 * i; att::glds16(KVX + (size_t)(64 * ft + lane) * 2048 + hh * 256 + 8 * c, (unsigned)__builtin_amdgcn_readfirstlane(dst + c * 1024)); }
    } else { const int vt = ft - 4;
#pragma unroll
        for (int i = 0; i < 4; ++i) { const int pv = wid + 8 * i, dblk = pv >> 2, kg = pv & 3;
            att::glds16(KVX + (size_t)(64 * vt + 16 * kg + (lane >> 2)) * 2048 + 1024 + hh * 256 + dblk * 32 + (lane & 3) * 8, (unsigned)__builtin_amdgcn_readfirstlane(dst + pv * 1024)); }
    }
}
__device__ __forceinline__ void unit(const Args& a, LAS unsigned char* L, int rb, int hh) {
    const int tid = threadIdx.x, lane = tid & 63, l15 = lane & 15, quad = lane >> 4;
    const int wid = __builtin_amdgcn_readfirstlane(tid >> 6);
    const bf16* QX = WSP(const bf16, WS_QX); const bf16* KVX = WSP(const bf16, WS_KVX); bf16* OX = WSP(bf16, WS_OX);
    const unsigned lds0 = (unsigned)(uintptr_t)L;
    const size_t row = (size_t)rb * 128 + 16 * wid + l15;
    asm volatile("s_waitcnt vmcnt(0)" ::: "memory");
    dma_tile(KVX, hh, 0, lds0, wid, lane); dma_tile(KVX, hh, 1, lds0 + SLOT, wid, lane);
    bf16x8 qr[8];
#pragma unroll
    for (int kk = 0; kk < 8; ++kk) qr[kk] = *(const bf16x8*)(QX + row * DM + hh * 256 + 32 * kk + 8 * quad);
    f32x4v S[16], O[16]; bf16x8 pb[8];
#pragma unroll
    for (int ft = 0; ft < 8; ++ft) {
        if (ft + 1 < 8) { ATT_WAIT_BAR(4); } else { ATT_WAIT_BAR(0); }
        if (ft + 2 < 8) dma_tile(KVX, hh, ft + 2, lds0 + ((ft + 2) % 3) * SLOT, wid, lane);
        const LAS char* sl = (const LAS char*)L + (ft % 3) * SLOT;
        if (ft < 4) {
#pragma unroll
            for (int tk = 0; tk < 4; ++tk) { f32x4v acc = {0.f, 0.f, 0.f, 0.f};
#pragma unroll
                for (int kk = 0; kk < 8; ++kk) acc = gdn::mfma16(*(const LAS bf16x8*)(sl + (4 * kk + quad) * 1024 + (16 * tk + l15) * 16), qr[kk], acc);
                S[4 * ft + tk] = acc; }
            if (ft == 3) {
                float m = S[0][0];
#pragma unroll
                for (int t = 0; t < 16; ++t)
#pragma unroll
                    for (int r = 0; r < 4; ++r) m = fmaxf(m, S[t][r]);
                m = fmaxf(m, __shfl_xor(m, 16)); m = fmaxf(m, __shfl_xor(m, 32));
                const float mc = m * CS; float sum = 0.f;
#pragma unroll
                for (int t = 0; t < 16; ++t)
#pragma unroll
                    for (int r = 0; r < 4; ++r) { const float p = __builtin_amdgcn_exp2f(S[t][r] * CS - mc); S[t][r] = p; sum += p; }
                sum += __shfl_xor(sum, 16); sum += __shfl_xor(sum, 32);
                const float inv = 1.f / sum;
#pragma unroll
                for (int ks = 0; ks < 8; ++ks) { u32x4v t; t[0] = gdn::cvtpk(S[2 * ks][0] * inv, S[2 * ks][1] * inv); t[1] = gdn::cvtpk(S[2 * ks][2] * inv, S[2 * ks][3] * inv);
                    t[2] = gdn::cvtpk(S[2 * ks + 1][0] * inv, S[2 * ks + 1][1] * inv); t[3] = gdn::cvtpk(S[2 * ks + 1][2] * inv, S[2 * ks + 1][3] * inv); pb[ks] = __builtin_bit_cast(bf16x8, t); }
#pragma unroll
                for (int td = 0; td < 16; ++td) O[td] = (f32x4v){0.f, 0.f, 0.f, 0.f};
            }
        } else { const int vt = ft - 4;
            const LAS char* vb = sl + (4 * quad + (l15 >> 2)) * 64 + (l15 & 3) * 8;
#pragma unroll
            for (int td = 0; td < 16; ++td)
#pragma unroll
                for (int kss = 0; kss < 2; ++kss) { const LAS char* p = vb + (td >> 1) * 4096 + (2 * kss) * 1024 + (td & 1) * 32;
                    const att::s16x4 lo = att::vtr(p), hi = att::vtr(p + 1024);
                    const bf16x8 vf = (bf16x8){lo[0], lo[1], lo[2], lo[3], hi[0], hi[1], hi[2], hi[3]};
                    O[td] = gdn::mfma16(vf, pb[2 * vt + kss], O[td]); }
        }
    }
    bf16* orow = OX + row * DM + hh * 256 + 4 * quad;
    if (FP8_X) { unsigned char* o8 = (unsigned char*)OX + row * DM + hh * 256 + 4 * quad;
#pragma unroll
        for (int td = 0; td < 16; ++td) *(unsigned*)(o8 + 16 * td) = pk4_fp8(O[td][0], O[td][1], O[td][2], O[td][3]); }
    else {
#pragma unroll
    for (int td = 0; td < 16; ++td) { u32x2v o; o[0] = gdn::cvtpk(O[td][0], O[td][1]); o[1] = gdn::cvtpk(O[td][2], O[td][3]); *(u32x2v*)(orow + 16 * td) = o; } }
    ATT_WAIT_BAR(0);
}
__device__ __forceinline__ void phase(const Args& a, LAS unsigned char* L, int G, int bid) {
    for (int u = bid; u < 512; u += G) unit(a, L, u >> 2, u & 3);
}
}
struct EpiProj {
    static constexpr bool PERM = true, AFTER_DRAIN = false;
    bf16* O; unsigned char* VI; int pno; float s8;
    __device__ __forceinline__ void operator()(const pg8::f32x4 (&acc)[2][2][4][2], const pg8::Unit& u, int wr, int wc, int fr, int fq) const {
        const int pn = u.pn + pno;
        const int row0 = u.pm * 256 + wr * 64 + fr, col0 = pn * 256 + wc * 32 + 8 * fq;
        if (PV_F8 && (pn == 4 || pn == 5)) {
#pragma unroll
            for (int ai = 0; ai < 2; ++ai)
#pragma unroll
                for (int m = 0; m < 4; ++m)
#pragma unroll
                    for (int bj = 0; bj < 2; ++bj) { const pg8::f32x4 v0 = acc[ai][bj][m][0] * s8, v1 = acc[ai][bj][m][1] * s8;
                        const int tok = row0 + ai * 128 + m * 16, cc = col0 + bj * 128 - PC_VA, hd = cc >> 7, d = cc & 127, key = tok & 63;
                        const int slot = (key & 0x33) | ((key & 4) << 1) | ((key & 8) >> 1);
                        v2u o; o.x = pk4_fp8(v0[0], v0[1], v0[2], v0[3]); o.y = pk4_fp8(v1[0], v1[1], v1[2], v1[3]);
                        *(v2u*)(VI + ((size_t)(hd * 256 + (tok >> 6)) * 8192 + (d >> 5) * 2048 + slot * 32 + (d & 31))) = o; }
            return; } const float sc = ((pn < 2) ? att::C2 : 1.f) * s8; const bool gate = pn >= 14;
#pragma unroll
        for (int ai = 0; ai < 2; ++ai)
#pragma unroll
            for (int m = 0; m < 4; ++m)
#pragma unroll
                for (int bj = 0; bj < 2; ++bj) { pg8::f32x4 v0 = acc[ai][bj][m][0] * sc, v1 = acc[ai][bj][m][1] * sc;
                    if (gate) { v0[0] = sigmoidf_(v0[0]); v0[1] = sigmoidf_(v0[1]); v0[2] = sigmoidf_(v0[2]); v0[3] = sigmoidf_(v0[3]); v1[0] = sigmoidf_(v1[0]); v1[1] = sigmoidf_(v1[1]); v1[2] = sigmoidf_(v1[2]); v1[3] = sigmoidf_(v1[3]); }
                    v4u o; o.x = pg8::cvt_pk_bf16(v0[0], v0[1]); o.y = pg8::cvt_pk_bf16(v0[2], v0[3]); o.z = pg8::cvt_pk_bf16(v1[0], v1[1]); o.w = pg8::cvt_pk_bf16(v1[2], v1[3]);
                    *(v4u*)(O + (size_t)(row0 + ai * 128 + m * 16) * NPROJ + col0 + bj * 128) = o; }
    }
};
#ifndef PHASE_MASK
#define PHASE_MASK 0xFFFFFFFFu
#endif
__global__ void __launch_bounds__(NTHR, 2) mk_fwd(Args a) {
    extern __shared__ __attribute__((aligned(16))) unsigned char lds[];
    LAS unsigned char* L = (LAS unsigned char*)lds;
    const int tid = threadIdx.x, lane = tid & 63, wave = __builtin_amdgcn_readfirstlane(tid >> 6);
    const int G = gridDim.x, bid = blockIdx.x;
    const int gw = bid * NWAVES + wave, NGW = G * NWAVES;
    gu32* ctl = (gu32*)(a.ws + WS_CTL);
    for (int u = tid; u < (LDS_BYTES - MISC_OFF) / 4; u += NTHR) ((LAS unsigned*)(L + MISC_OFF))[u] = 0u;
    __syncthreads();
    const int lo = a.ph_lo, hi = a.ph_hi;
    const bool one = (hi - lo) > 1;
    XcdBarrier bar; bar.bar = (unsigned*)ctl + CW_BAR; bar.x = 0; bar.st = nullptr;
    if (one) bar = xcd_barrier_post((unsigned*)ctl + CW_BAR, (volatile LAS unsigned*)(L + MISC_OFF) + 8);
#define IN(k) (((PHASE_MASK >> (k)) & 1u) && lo <= (k) && (k) < hi)
#define SEAM(k) do { if (IN(k) && IN((k) + 1)) xcd_barrier(bar); } while (0)
#define PH_BEGIN(k) if (IN(k)) { const __attribute__((address_space(4))) Args* ap_ = (const __attribute__((address_space(4))) Args*)__builtin_amdgcn_kernarg_segment_ptr(); asm volatile("" : "+s"(ap_)); const Args& a = *(const Args*)ap_;
#define PH_END(k) } SEAM(k);
    constexpr bool AL = true, SP = true;

    PH_BEGIN(0) phase_prep(a, L, tid, lane, wave, G, bid); PH_END(0)
    PH_BEGIN(1)
        { constexpr int NB = GATE_F8 ? 3072 : NPROJ;
          pg8::Gemm g{WSP(const bf16, WS_H), WSP(const bf16, WS_WT_IN), SEQ, NB, DM}; pg8::StaticOrder S; S.init(SEQ, NB, G, bid);
          EpiProj E{WSP(bf16, WS_PROJ), (unsigned char*)a.ws + WS_VIMG, 0, FP8_IN ? 1.f / W8_SCALE : 1.f}; pg8::gemm_phase<EpiProj, pg8::StaticOrder, AL, SP, false, FP8_IN != 0>(L, g, S, E); }
        if (GATE_F8) { pg8::Gemm g{WSP(const bf16, WS_H8), WSP(const bf16, WS_WT_IN8), SEQ, NPROJ - 3072, DM}; pg8::StaticOrder S; S.init(SEQ, NPROJ - 3072, G, bid);
          EpiProj E{WSP(bf16, WS_PROJ), (unsigned char*)a.ws + WS_VIMG, 12, 1.f / W8_SCALE}; pg8::gemm_phase<EpiProj, pg8::StaticOrder, AL, SP, false, true>(L, g, S, E); }
    PH_END(1)
    PH_BEGIN(2) gdn::chunk_units(a, L, tid, G, bid); PH_END(2)
    PH_BEGIN(3)
        if (bid < 8) gdn::scan_wg(a, L, tid, bid & 3, bid >> 2);
        else if (bid < 8 + 32) {
            prep_moe_pf(a, (LAS float*)(L + wave * 16640), lane, (bid - 8) * NWAVES + wave, 32 * NWAVES); }
        if (bid >= G - 8) {
            pg8::Gemm g{WSP(const bf16, WS_MEMN), WSP(const bf16, WS_WT_KV), NMEM, 2048, DM}; att::OneUnit S{bid - (G - 8)};
            pg8::EpiBf16<0> E{WSP(bf16, WS_KVX), 2048, nullptr, 0, 0, 1.f}; pg8::gemm_phase<pg8::EpiBf16<0>, att::OneUnit, AL, SP>(L, g, S, E); }
        __syncthreads();
        att::build_tables(a, L, tid);
        att::attn_queue(a, L, tid);
#if defined(PROBE_REPEAT3)
        xcd_barrier(bar);
        if (bid < 8) gdn::scan_wg(a, L, tid, bid & 3, bid >> 2);
        __syncthreads();
        att::attn_queue(a, L, tid, 64);
#endif
    PH_END(3)
    PH_BEGIN(4) phase_gdn_post(a, lane, gw, NGW); PH_END(4)
    PH_BEGIN(5)
        { pg8::Gemm g{WSP(const bf16, WS_OA), WSP(const bf16, WS_WT_UPA), SEQ, DM, 512}; pg8::StaticOrder S; S.init(SEQ, DM, G, bid);
          EpiGate<false> E{WSP(const bf16, WS_PROJ), WSP(bf16, WS_MRG)}; pg8::gemm_phase<EpiGate<false>, pg8::StaticOrder, AL, SP>(L, g, S, E); }
        { pg8::Gemm g{WSP(const bf16, WS_OB), WSP(const bf16, WS_WT_UPB), SEQ, DM, 512}; pg8::StaticOrder S; S.init(SEQ, DM, G, bid);
          EpiGate<true> E{WSP(const bf16, WS_PROJ), WSP(bf16, WS_MRG)}; pg8::gemm_phase<EpiGate<true>, pg8::StaticOrder, AL, SP>(L, g, S, E); }
    PH_END(5)
    PH_BEGIN(6) { pg8::Gemm g{WSP(const bf16, WS_MRG), WSP(const bf16, WS_WT_OUT), SEQ, DM, DM}; pg8::StaticOrder S; S.init(SEQ, DM, G, bid);
        EpiResidStat<false> E{a.in[0], WSP(bf16, WS_XB), WSP(float, WS_SS), FP8_X ? WSP(unsigned char, WS_X8) : nullptr, 1.f}; pg8::gemm_phase<EpiResidStat<false>, pg8::StaticOrder, AL, SP>(L, g, S, E); } PH_END(6)
    PH_BEGIN(7) { pg8::Gemm g{WSP(const bf16, FP8_X ? WS_X8 : WS_H), WSP(const bf16, WS_WT_QX), SEQ, DM, DM}; pg8::StaticOrder S; S.init(SEQ, DM, G, bid);
        EpiRowScale E{WSP(bf16, WS_QX), WSP(const float, WS_SS)}; pg8::gemm_phase<EpiRowScale, pg8::StaticOrder, AL, SP, false, FP8_X != 0>(L, g, S, E); } PH_END(7)
    PH_BEGIN(8) xat::phase(a, L, G, bid); PH_END(8)
    PH_BEGIN(9) { pg8::Gemm g{WSP(const bf16, WS_OX), WSP(const bf16, WS_WT_OX), SEQ, DM, DM}; pg8::StaticOrder S; S.init(SEQ, DM, G, bid);
        EpiResidStat<true> E{nullptr, WSP(bf16, WS_XB), WSP(float, WS_SS), MOE_F8 ? WSP(unsigned char, WS_X8) : nullptr, FP8_X ? 1.f / W8_SCALE : 1.f}; pg8::gemm_phase<EpiResidStat<true>, pg8::StaticOrder, AL, SP, false, FP8_X != 0>(L, g, S, E); } PH_END(9)
    PH_BEGIN(10) phase_router(a, lds, lane, wave, gw, NGW); PH_END(10)
    PH_BEGIN(11) phase_slots(a, lds, tid, lane, wave, G, bid); PH_END(11)
    PH_BEGIN(12) { moe_tables(a, lds, tid, 0); const LAS int* X = (const LAS int*)(L + EXTRA_OFF);
        pg8::Gemm g{WSP(const bf16, MOE_F8 ? WS_X8 : WS_XB), WSP(const bf16, WS_W1T), 0, 0, DM, WSP(const int, WS_SLOTT)}; MoeOrder S{G, bid, 8, X[96] * 8, X + 128};
        EpiSwiglu E{WSP(bf16, WS_ACT), a.in[26], WSP(const float, WS_SLOTR)}; pg8::gemm_phase<EpiSwiglu, MoeOrder, AL, SP, true, MOE_F8 != 0>(L, g, S, E); } PH_END(12)
    PH_BEGIN(13) { moe_tables(a, lds, tid, 0); const LAS int* X = (const LAS int*)(L + EXTRA_OFF);
        pg8::Gemm g{WSP(const bf16, WS_ACT), WSP(const bf16, WS_W2T), 0, 0, DM}; MoeOrder S{G, bid, 4, X[96] * 4, X + 128};
        EpiMoeOut E{WSP(bf16, WS_YS), a.in[28], WSP(const float, WS_SLOTW)}; pg8::gemm_phase<EpiMoeOut, MoeOrder, AL, SP, false, MOE_F8 != 0>(L, g, S, E); } PH_END(13)
    PH_BEGIN(14) phase_final(a, lane, gw, NGW); PH_END(14)
#undef IN
#undef SEAM
}

#ifndef N_LAUNCH_MODE
#define N_LAUNCH_MODE 1
#endif
extern "C" void kernel_launch(void* const* d_in, const int* in_sizes, int n_in, void* d_out, int out_size, void* d_ws, size_t ws_size, hipStream_t stream) {
    static int grid = 0;
    if (grid == 0) {
        if (n_in != 30 || out_size != SEQ * DM || ws_size < WS_END) { fprintf(stderr, "kernel_launch: unexpected shapes (n_in %d out %d ws %zu)\n", n_in, out_size, ws_size); grid = -1; return; }
        int dev = 0, cus = 0;
        if (hipGetDevice(&dev) != hipSuccess || hipDeviceGetAttribute(&cus, hipDeviceAttributeMultiprocessorCount, dev) != hipSuccess) { grid = -1; return; }
        if (hipFuncSetAttribute((const void*)mk_fwd, hipFuncAttributeMaxDynamicSharedMemorySize, LDS_BYTES) != hipSuccess) { fprintf(stderr, "kernel_launch: hipFuncSetAttribute failed\n"); grid = -1; return; }
        int per_cu = 0; (void)hipOccupancyMaxActiveBlocksPerMultiprocessor(&per_cu, (const void*)mk_fwd, NTHR, LDS_BYTES); (void)hipGetLastError();
        grid = cus;
    }
    if (grid < 0) return;
    (void)hipMemsetAsync((char*)d_ws + WS_CTL, 0, CTL_ZERO_BYTES, stream);
    Args a{};
    for (int i = 0; i < 30; ++i) a.in[i] = (const float*)d_in[i];
    a.out = (float*)d_out; a.ws = (unsigned char*)d_ws;
#if N_LAUNCH_MODE
    a.ph_lo = 0; a.ph_hi = NPH; hipLaunchKernelGGL(mk_fwd, dim3(grid), dim3(NTHR), LDS_BYTES, stream, a);
#else
    for (int p = 0; p < NPH; ++p) { a.ph_lo = p; a.ph_hi = p + 1; hipLaunchKernelGGL(mk_fwd, dim3(grid), dim3(NTHR), LDS_BYTES, stream, a); }
#endif
}
```

```cpp
#include <hip/hip_runtime.h>
#include <cstdio>
#include <cstdint>
namespace pg8 {
#define PG8_LAS __attribute__((address_space(3)))
typedef unsigned short bf16_t;
typedef short bf16x8 __attribute__((ext_vector_type(8)));
typedef float f32x4 __attribute__((ext_vector_type(4)));
typedef unsigned u32x4 __attribute__((ext_vector_type(4)));
typedef int i32x8_ __attribute__((ext_vector_type(8)));
typedef short s16x16_ __attribute__((ext_vector_type(16)));
constexpr int BM = 256, BK = 64, HALF = 128, HTB = HALF * BK * 2  , STAGE_BYTES = 8 * HTB, NXCD = 8, WGM = 8;

__host__ __device__ __forceinline__ int lds_byte(int r, int c) { const int st = (r >> 4) * 2 + (c >> 5), rr = r & 15, cc = c & 31, ob = rr * 64 + cc * 2; return st * 1024 + (ob ^ (((ob >> 9) & 1) << 5)); }
__host__ __device__ __forceinline__ void stage_rc(int b, int& R, int& C) { const int st = b / 1024, sb = b % 1024, swz = sb ^ (((sb >> 9) & 1) << 5); R = (st >> 1) * 16 + swz / 64; C = (st & 1) * 32 + (swz % 64) / 2; }
__host__ __device__ __forceinline__ int perm32(int rho) { const int n = rho >> 4, i = rho & 15; return 8 * (i >> 2) + 4 * n + (i & 3); }

struct Unit { int pm, pn; };
struct Gemm { const bf16_t* A; const bf16_t* Bt; int M, N, K; const int* tok; };

struct StaticOrder {
    int nM, nN, nwg, G, c;
    __host__ __device__ void init(int M, int N, int G_, int c_) { nM = M / BM; nN = N / BM; nwg = nM * nN; G = G_; c = c_; }
    __host__ __device__ __forceinline__ bool next(int i, Unit& u) const {
        const long L = (long)i * G + c; if (L >= nwg) return false;
        int wgid = (int)L; { const int q = nwg / NXCD, r = nwg % NXCD, xcd = wgid % NXCD, off = wgid / NXCD; wgid = (xcd < r ? xcd * (q + 1) : r * (q + 1) + (xcd - r) * q) + off; }
        const int nig = WGM * nN, gid = wgid / nig, fm = gid * WGM, gsz = (nM - fm) < WGM ? (nM - fm) : WGM;
        u.pm = fm + ((wgid % nig) % gsz); u.pn = (wgid % nig) / gsz; return true;
    }
    __device__ __forceinline__ void a_ready(const Unit&) const {}
    __device__ __forceinline__ void done(const Unit&) const {}
};

__device__ __forceinline__ unsigned cvt_pk_bf16(float lo, float hi) { unsigned r; asm volatile("v_cvt_pk_bf16_f32 %0, %1, %2" : "=v"(r) : "v"(lo), "v"(hi)); return r; }
typedef float f32x2 __attribute__((ext_vector_type(2)));
__device__ __forceinline__ f32x2 gelu_pk(f32x2 v) {
    const f32x2 av = __builtin_elementwise_abs(v), d = av * 0.2316418882f + 1.0f;
    f32x2 t; t.x = __builtin_amdgcn_rcpf(d.x); t.y = __builtin_amdgcn_rcpf(d.y);
    f32x2 q = t * 0.5307027145f + (-0.7265760135f); q = q * t + 0.7107068705f; q = q * t + (-0.142248368f); q = q * t + 0.127414796f; q = q * t;
    const f32x2 s = (v * v) * (-0.72134752044f);
    f32x2 e; e.x = __builtin_amdgcn_exp2f(s.x); e.y = __builtin_amdgcn_exp2f(s.y);
    const f32x2 m = v * (q * e), r = v - m;
    f32x2 o; o.x = v.x < 0.f ? m.x : r.x; o.y = v.y < 0.f ? m.y : r.y; return o;
}

template <int ACT  > struct EpiBf16 {
    static constexpr bool PERM = true, AFTER_DRAIN = false; static_assert(ACT == 0 || ACT == 1, "EpiBf16: ACT is 0 (none) or 1 (gelu_pk)");
    bf16_t* O; int ldc; const float* bias; int split_cols; size_t split_stride; float scale0;
    __device__ __forceinline__ void operator()(const f32x4 (&acc)[2][2][4][2], const Unit& u, int wr, int wc, int fr, int fq) const {
        const int row0 = u.pm * BM + wr * 64 + fr; int colt = u.pn * BM; bf16_t* base = O;
        float sc = 1.f; if (split_cols) { const int t = colt / split_cols; base += (size_t)t * split_stride; colt -= t * split_cols; if (t == 0) sc = scale0; }
        const int col0 = colt + wc * 32 + 8 * fq, bcol0 = u.pn * BM + wc * 32 + 8 * fq;
        f32x4 bv[2][2];
#pragma unroll
        for (int bj = 0; bj < 2; ++bj)
#pragma unroll
            for (int n = 0; n < 2; ++n) bv[bj][n] = bias ? *(const f32x4*)(bias + bcol0 + bj * HALF + 4 * n) : (f32x4){0.f, 0.f, 0.f, 0.f};
#pragma unroll
        for (int ai = 0; ai < 2; ++ai)
#pragma unroll
            for (int m = 0; m < 4; ++m) { bf16_t* rowp = base + (size_t)(row0 + ai * HALF + m * 16) * ldc + col0;
#pragma unroll
                for (int bj = 0; bj < 2; ++bj) { f32x4 v0 = acc[ai][bj][m][0] + bv[bj][0], v1 = acc[ai][bj][m][1] + bv[bj][1];
                    if (ACT == 1) { f32x2 a = gelu_pk((f32x2){v0[0], v0[1]}), b = gelu_pk((f32x2){v0[2], v0[3]}), c = gelu_pk((f32x2){v1[0], v1[1]}), d = gelu_pk((f32x2){v1[2], v1[3]});
                        v0 = (f32x4){a.x, a.y, b.x, b.y}; v1 = (f32x4){c.x, c.y, d.x, d.y}; }
                    v0 = v0 * sc; v1 = v1 * sc; u32x4 w; w.x = cvt_pk_bf16(v0[0], v0[1]); w.y = cvt_pk_bf16(v0[2], v0[3]); w.z = cvt_pk_bf16(v1[0], v1[1]); w.w = cvt_pk_bf16(v1[2], v1[3]);
                    *(u32x4*)(rowp + bj * HALF) = w; } }
    }
};
template <class E_> constexpr auto midk_of(int) -> decltype(E_::MIDK_T) { return E_::MIDK_T; }
template <class E_> constexpr int midk_of(long) { return -1; }
template <class E_> constexpr auto pair_of(int) -> decltype(E_::PAIRED) { return E_::PAIRED; }
template <class E_> constexpr bool pair_of(long) { return false; }
template <class Epi, class Sched, bool ALIGN_EPI = false, bool SP2 = false, bool GATHER = false, bool F8 = false>
__device__ __forceinline__ void gemm_phase(PG8_LAS unsigned char* lds, const Gemm g, const Sched& S, const Epi& E) {
    static_assert(!GATHER || SP2, "GATHER is wired into the SP2 loop only");
    const int tid = threadIdx.x, wid = __builtin_amdgcn_readfirstlane(tid >> 6), lane = tid & 63, wr = wid >> 2, wc = wid & 3, fr = lane & 15, fq = lane >> 4;
    const int K = g.K, KB = F8 ? g.K : g.K * 2, nt = KB / (BK * 2);
    unsigned voffA[2], voffB[2];
#pragma unroll
    for (int i = 0; i < 2; ++i) { int R, C; stage_rc(tid * 16 + i * 8192, R, C); const int Rb = Epi::PERM ? ((R & ~31) + perm32(R & 31)) : R;
        voffA[i] = (unsigned)(R * KB + C * 2); voffB[i] = (unsigned)(Rb * KB + C * 2); }
    unsigned goffC[2][2] = {{0u, 0u}, {0u, 0u}}, goffN[2][2] = {{0u, 0u}, {0u, 0u}};
#define PG8_GOFF(dst, u_) do { _Pragma("unroll") for (int h_ = 0; h_ < 2; ++h_) _Pragma("unroll") for (int i_ = 0; i_ < 2; ++i_) \
        { int R_, C_; stage_rc(tid * 16 + i_ * 8192, R_, C_); dst[h_][i_] = (unsigned)(g.tok[(u_).pm * BM + h_ * HALF + R_] * KB + C_ * 2); } asm volatile("" : "+v"(dst[0][0]), "+v"(dst[0][1]), "+v"(dst[1][0]), "+v"(dst[1][1])); } while (0)
    const size_t kstep = (size_t)(BK * 2);
    const size_t hstep = (size_t)HALF * KB;
    const size_t tstep = 2 * hstep;
    const unsigned ldsw = (unsigned)wid * 1024u;
    const int aoffk[2] = {lds_byte(wr * 64 + fr, F8 ? 16 * fq : fq * 8), lds_byte(wr * 64 + fr, F8 ? 16 * fq + 8 : fq * 8 + 32)};
    const int boffk[2] = {lds_byte(wc * 32 + fr, F8 ? 16 * fq : fq * 8), lds_byte(wc * 32 + fr, F8 ? 16 * fq + 8 : fq * 8 + 32)};
#define PG8_SA(b, h) (((b) * 2 + (h)) * HTB)
#define PG8_SB(b, h) ((4 + (b) * 2 + (h)) * HTB)
#define PG8_STAGE(bufoff, gbase, voff) do { _Pragma("unroll") for (int _i = 0; _i < 2; ++_i) \
        __builtin_amdgcn_global_load_lds((const unsigned*)((const char*)(gbase) + (voff)[_i]), (PG8_LAS unsigned*)(lds + (bufoff) + ldsw + _i * 8192), 16, 0, 0); } while (0)
#define PG8_STAGE_A(b, h, ptr, useN) do { if constexpr (GATHER) { if (useN) PG8_STAGE(PG8_SA(b, h), ptr, goffN[h]); else PG8_STAGE(PG8_SA(b, h), ptr, goffC[h]); } \
        else PG8_STAGE(PG8_SA(b, h), (ptr) + ((h) ? hstep : 0), voffA); } while (0)
#define PG8_LDA(dst, b, h) do { if constexpr (!F8) _Pragma("unroll") for (int m = 0; m < 4; ++m) _Pragma("unroll") for (int k = 0; k < 2; ++k) dst[m][k] = *(const PG8_LAS bf16x8*)(lds + PG8_SA(b, h) + aoffk[k] + m * 2048); if constexpr (F8) { _Pragma("unroll") for (int m = 0; m < 4; ++m) dst##8[m] = __builtin_bit_cast(i32x8_, __builtin_shufflevector(*(const PG8_LAS bf16x8*)(lds + PG8_SA(b, h) + aoffk[0] + m * 2048), *(const PG8_LAS bf16x8*)(lds + PG8_SA(b, h) + aoffk[0] + m * 2048 + 16), 0, 1, 2, 3, 4, 5, 6, 7, 8, 9, 10, 11, 12, 13, 14, 15)); } } while (0)
#define PG8_LDB(dst, b, h) do { if constexpr (!F8) _Pragma("unroll") for (int n = 0; n < 2; ++n) _Pragma("unroll") for (int k = 0; k < 2; ++k) dst[n][k] = *(const PG8_LAS bf16x8*)(lds + PG8_SB(b, h) + boffk[k] + n * 2048); if constexpr (F8) { _Pragma("unroll") for (int n = 0; n < 2; ++n) dst##8[n] = __builtin_bit_cast(i32x8_, __builtin_shufflevector(*(const PG8_LAS bf16x8*)(lds + PG8_SB(b, h) + boffk[0] + n * 2048), *(const PG8_LAS bf16x8*)(lds + PG8_SB(b, h) + boffk[0] + n * 2048 + 16), 0, 1, 2, 3, 4, 5, 6, 7, 8, 9, 10, 11, 12, 13, 14, 15)); } } while (0)
#define PG8_MMA(ai, bj, At, Bt) do { __builtin_amdgcn_s_setprio(1); _Pragma("unroll") for (int m = 0; m < 4; ++m) _Pragma("unroll") for (int n = 0; n < 2; ++n) { \
        if constexpr (F8) asm volatile("v_mfma_scale_f32_16x16x128_f8f6f4 %0, %1, %2, %0, %3, %3 op_sel_hi:[0,0,0]" : "+v"(acc[ai][bj][m][n]) : "v"(Bt##8[n]), "v"(At##8[m]), "v"(0x7f7f7f7f));   \
        else { _Pragma("unroll") for (int k = 0; k < 2; ++k) acc[ai][bj][m][n] = __builtin_amdgcn_mfma_f32_16x16x32_bf16(Bt[n][k], At[m][k], acc[ai][bj][m][n], 0, 0, 0); } } \
        __builtin_amdgcn_s_setprio(0); } while (0)
#define PG8_WAIT_V(n) asm volatile("s_waitcnt vmcnt(" #n ")" ::: "memory")
#define PG8_WAIT_L(n) asm volatile("s_waitcnt lgkmcnt(" #n ")" ::: "memory")
#define PG8_BAR __builtin_amdgcn_s_barrier()
#define PG8_SCHED __builtin_amdgcn_sched_barrier(0)
    Unit cur, nxt; int ui = 0;
    if (!S.next(0, cur)) return;
    f32x4 acc[2][2][4][2];
#pragma unroll
    for (int a = 0; a < 2; ++a)
#pragma unroll
        for (int b = 0; b < 2; ++b)
#pragma unroll
            for (int m = 0; m < 4; ++m)
#pragma unroll
                for (int n = 0; n < 2; ++n) acc[a][b][m][n] = (f32x4){0.f, 0.f, 0.f, 0.f};
    bf16x8 At[4][2], B0[2][2], B1[2][2];
    i32x8_ At8[4], B08[2], B18[2];
    const char* cA = (const char*)g.A + (GATHER ? (size_t)0 : (size_t)cur.pm * tstep); const char* cB = (const char*)g.Bt + (size_t)cur.pn * tstep;
    if constexpr (GATHER) { PG8_GOFF(goffC, cur); Unit n1_; if (S.next(1, n1_)) PG8_GOFF(goffN, n1_); }
    S.a_ready(cur);
    if constexpr (SP2) {
        PG8_STAGE(PG8_SB(0, 0), cB, voffB); PG8_STAGE(PG8_SB(0, 1), cB + hstep, voffB); PG8_STAGE_A(0, 0, cA, false); PG8_STAGE_A(0, 1, cA, false);
        if (wr == 1) PG8_BAR;
        PG8_WAIT_V(2); PG8_BAR;
        PG8_STAGE(PG8_SB(1, 0), cB + kstep, voffB); PG8_STAGE_A(1, 0, cA + kstep, false); PG8_STAGE(PG8_SB(1, 1), cB + hstep + kstep, voffB);
        PG8_WAIT_V(6); PG8_BAR;
    } else {
        PG8_STAGE(PG8_SB(0, 0), cB, voffB); PG8_STAGE(PG8_SA(0, 0), cA, voffA); PG8_STAGE(PG8_SB(0, 1), cB + hstep, voffB); PG8_STAGE(PG8_SA(0, 1), cA + hstep, voffA);
        if (wr == 1) PG8_BAR;
        PG8_WAIT_V(4); PG8_BAR;
        PG8_STAGE(PG8_SB(1, 0), cB + kstep, voffB); PG8_STAGE(PG8_SA(1, 0), cA + kstep, voffA); PG8_STAGE(PG8_SB(1, 1), cB + hstep + kstep, voffB);
        PG8_WAIT_V(6); PG8_BAR;
    }
    for (;;) {
        const bool has_next = S.next(ui + 1, nxt);
        const char* nA = (has_next && !GATHER) ? (const char*)g.A + (size_t)nxt.pm * tstep : cA; const char* nB = has_next ? (const char*)g.Bt + (size_t)nxt.pn * tstep : cB;
#define PG8_KBODY \
            const bool last = (t == nt - 2); \
            const char* a1 = cA + (size_t)(t + 1) * kstep; \
            const char* a2 = last ? nA : cA + (size_t)(t + 2) * kstep; const char* b2 = last ? nB : cB + (size_t)(t + 2) * kstep; \
            const char* a3 = a2 + kstep; const char* b3 = b2 + kstep; \
            if (last && has_next) S.a_ready(nxt); \
            const bool useN = last && has_next; \
            if constexpr (SP2) { \
            PG8_LDB(B0, 0, 0); PG8_LDB(B1, 0, 1); PG8_SCHED; PG8_LDA(At, 0, 0); PG8_STAGE_A(1, 1, a1, false); \
            PG8_WAIT_V(8); PG8_WAIT_L(0); PG8_BAR; PG8_MMA(0, 0, At, B0); PG8_MMA(0, 1, At, B1); PG8_BAR; PG8_SCHED; \
            PG8_LDA(At, 0, 1); PG8_STAGE(PG8_SB(0, 0), b2, voffB); PG8_STAGE(PG8_SB(0, 1), b2 + hstep, voffB); PG8_STAGE_A(0, 0, a2, useN); \
            PG8_WAIT_V(8); PG8_WAIT_L(0); PG8_BAR; PG8_MMA(1, 0, At, B0); PG8_MMA(1, 1, At, B1); PG8_BAR; PG8_SCHED; \
            PG8_LDB(B0, 1, 0); PG8_LDB(B1, 1, 1); PG8_SCHED; PG8_LDA(At, 1, 0); PG8_STAGE_A(0, 1, a2, useN); \
            PG8_WAIT_V(8); PG8_WAIT_L(0); PG8_BAR; PG8_MMA(0, 0, At, B0); PG8_MMA(0, 1, At, B1); PG8_BAR; PG8_SCHED; \
            PG8_LDA(At, 1, 1); PG8_STAGE(PG8_SB(1, 0), b3, voffB); PG8_STAGE(PG8_SB(1, 1), b3 + hstep, voffB); PG8_STAGE_A(1, 0, a3, useN); \
            PG8_WAIT_V(8); PG8_WAIT_L(0); PG8_BAR; PG8_MMA(1, 0, At, B0); PG8_MMA(1, 1, At, B1); PG8_BAR; PG8_SCHED; \
            } else { \
            PG8_LDB(B0, 0, 0); PG8_SCHED; PG8_LDA(At, 0, 0); PG8_STAGE(PG8_SA(1, 1), a1 + hstep, voffA); \
            PG8_WAIT_L(8); PG8_BAR; PG8_WAIT_L(0); PG8_MMA(0, 0, At, B0); PG8_BAR; PG8_SCHED; \
            PG8_LDB(B1, 0, 1); PG8_STAGE(PG8_SB(0, 0), b2, voffB); \
            PG8_BAR; PG8_WAIT_L(0); PG8_MMA(0, 1, At, B1); PG8_BAR; \
            PG8_LDA(At, 0, 1); PG8_STAGE(PG8_SA(0, 0), a2, voffA); \
            PG8_BAR; PG8_WAIT_L(0); PG8_MMA(1, 0, At, B0); PG8_BAR; PG8_SCHED; \
            PG8_STAGE(PG8_SB(0, 1), b2 + hstep, voffB); \
            PG8_WAIT_V(6); PG8_BAR; PG8_MMA(1, 1, At, B1); PG8_BAR; \
            PG8_LDB(B0, 1, 0); PG8_SCHED; PG8_LDA(At, 1, 0); PG8_STAGE(PG8_SA(0, 1), a2 + hstep, voffA); \
            PG8_WAIT_L(8); PG8_BAR; PG8_WAIT_L(0); PG8_MMA(0, 0, At, B0); PG8_BAR; PG8_SCHED; \
            PG8_LDB(B1, 1, 1); PG8_STAGE(PG8_SB(1, 0), b3, voffB); \
            PG8_BAR; PG8_WAIT_L(0); PG8_MMA(0, 1, At, B1); PG8_BAR; \
            PG8_LDA(At, 1, 1); PG8_STAGE(PG8_SA(1, 0), a3, voffA); \
            PG8_BAR; PG8_WAIT_L(0); PG8_MMA(1, 0, At, B0); PG8_BAR; PG8_SCHED; \
            PG8_STAGE(PG8_SB(1, 1), b3 + hstep, voffB); \
            PG8_WAIT_V(6); PG8_BAR; PG8_MMA(1, 1, At, B1); PG8_BAR; \
            } \

        { int t = 0;
          if constexpr (midk_of<Epi>(0) >= 0) { for (; t < midk_of<Epi>(0); t += 2) { PG8_KBODY } E.mid(acc, cur, wr, wc, fr, fq); }
          _Pragma("unroll 1") for (; t < nt; t += 2) { PG8_KBODY } }
#undef PG8_KBODY
        if constexpr (ALIGN_EPI) { if (wr == 0) PG8_BAR; }
        if constexpr (F8) asm volatile("s_nop 15\n\ts_nop 15" ::: "memory");
        int tokN[2][2] = {{0, 0}, {0, 0}}; bool has2 = false;
        if constexpr (GATHER) { Unit n2p_; has2 = S.next(ui + 2, n2p_);
            if (has2) { _Pragma("unroll") for (int h_ = 0; h_ < 2; ++h_) _Pragma("unroll") for (int i_ = 0; i_ < 2; ++i_) { int R_, C_; stage_rc(tid * 16 + i_ * 8192, R_, C_); tokN[h_][i_] = g.tok[n2p_.pm * BM + h_ * HALF + R_]; } } }
        bool keep = false;
        if constexpr (pair_of<Epi>(0)) { keep = Epi::keep(cur); if (keep) E.first(acc, cur, wr, wc, fr, fq); else E(acc, cur, wr, wc, fr, fq); S.done(cur); }
        else if constexpr (!Epi::AFTER_DRAIN) { E(acc, cur, wr, wc, fr, fq); S.done(cur); }
        if (!has_next) break;
        if (!keep)
#pragma unroll
        for (int a = 0; a < 2; ++a)
#pragma unroll
            for (int b = 0; b < 2; ++b)
#pragma unroll
                for (int m = 0; m < 4; ++m)
#pragma unroll
                    for (int n = 0; n < 2; ++n) acc[a][b][m][n] = (f32x4){0.f, 0.f, 0.f, 0.f};
        cur = nxt; cA = nA; cB = nB; ++ui;
        if constexpr (GATHER) { _Pragma("unroll") for (int h_ = 0; h_ < 2; ++h_) _Pragma("unroll") for (int i_ = 0; i_ < 2; ++i_) goffC[h_][i_] = goffN[h_][i_];
            if (has2) { _Pragma("unroll") for (int h_ = 0; h_ < 2; ++h_) _Pragma("unroll") for (int i_ = 0; i_ < 2; ++i_) { int R_, C_; stage_rc(tid * 16 + i_ * 8192, R_, C_); goffN[h_][i_] = (unsigned)(tokN[h_][i_] * KB + C_ * 2); }
                asm volatile("" : "+v"(goffN[0][0]), "+v"(goffN[0][1]), "+v"(goffN[1][0]), "+v"(goffN[1][1])); } }
        if constexpr (ALIGN_EPI) { if (wr == 1) PG8_BAR; }
    }
    PG8_WAIT_V(0);
    if constexpr (!ALIGN_EPI) { if (wr == 0) PG8_BAR; }
    PG8_BAR;
    if constexpr (Epi::AFTER_DRAIN) { E.fused(acc, cur, wr, wc, fr, fq, lds, wid, lane); S.done(cur); }
#undef PG8_SA
#undef PG8_SB
#undef PG8_STAGE
#undef PG8_STAGE_A
#undef PG8_GOFF
#undef PG8_LDA
#undef PG8_LDB
#undef PG8_MMA
#undef PG8_WAIT_V
#undef PG8_WAIT_L
#undef PG8_BAR
#undef PG8_SCHED
}
}

#define GAS __attribute__((address_space(1)))
#define LAS __attribute__((address_space(3)))
typedef unsigned short bf16;
typedef unsigned v4u __attribute__((ext_vector_type(4)));
typedef unsigned v2u __attribute__((ext_vector_type(2)));
typedef float f32x4 __attribute__((ext_vector_type(4)));
typedef GAS unsigned gu32;
#define RLX_AGENT __ATOMIC_RELAXED, __HIP_MEMORY_SCOPE_AGENT
#define LDS_WAIT() asm volatile("s_waitcnt lgkmcnt(0)" ::: "memory")
#define VM_WAIT() asm volatile("s_waitcnt vmcnt(0)" ::: "memory")
__device__ __forceinline__ unsigned f2bf(float f) { unsigned u = __builtin_bit_cast(unsigned, f); return (u + 0x7fffu + ((u >> 16) & 1u)) >> 16; }
__device__ __forceinline__ unsigned pk2(float lo, float hi) { return f2bf(lo) | (f2bf(hi) << 16); }
__device__ __forceinline__ float bflo(unsigned w) { return __builtin_bit_cast(float, w << 16); }
__device__ __forceinline__ float bfhi(unsigned w) { return __builtin_bit_cast(float, w & 0xffff0000u); }
__device__ __forceinline__ float bf2f(bf16 b) { return __builtin_bit_cast(float, (unsigned)b << 16); }
__device__ __forceinline__ float sigmoidf_(float x) { return __builtin_amdgcn_rcpf(1.f + __expf(-x)); }
__device__ __forceinline__ float siluf_(float x) { return x * __builtin_amdgcn_rcpf(1.f + __expf(-x)); }
__device__ __forceinline__ float wave_sum(float v) {
#pragma unroll
    for (int o = 1; o < 64; o <<= 1) v += __shfl_xor(v, o);
    return v;
}
#define XB_TMO      128
#define XB_XCNT(j)  (256  + 64 * (j))
#define XB_XSUB(j)  (1280 + 64 * (j))
#define XB_XGEN(j)  (2304 + 64 * (j))
#define XB_TOP      3328
#define XB_TOPGEN   3392
#define XCD_BAR_WORDS 3456
#define XB_SPIN_CAP (1u << 18)

__device__ __forceinline__ unsigned xb_ld(unsigned* p)              { return __hip_atomic_load(p, __ATOMIC_RELAXED, __HIP_MEMORY_SCOPE_AGENT); }
__device__ __forceinline__ unsigned xb_add(unsigned* p, unsigned v) { return __hip_atomic_fetch_add(p, v, __ATOMIC_RELAXED, __HIP_MEMORY_SCOPE_AGENT); }
__device__ __forceinline__ unsigned xb_xcc_id() { return (unsigned)__builtin_amdgcn_s_getreg((3 << 11) | 20) & 0xFu; }
#define XB_SPIN(cond, bar) do { unsigned _sp = 0; while (cond) { __builtin_amdgcn_s_sleep(1); \
    if ((++_sp & 255u) == 0u) { if (xb_ld(&(bar)[XB_TMO])) break; if (_sp > XB_SPIN_CAP) { atomicAdd(&(bar)[XB_TMO], 1u); break; } } } } while (0)

struct XcdBarrier {
    unsigned* bar; unsigned x;
    volatile LAS unsigned* st;
};

__device__ __forceinline__ XcdBarrier xcd_barrier_post(unsigned* bar, volatile LAS unsigned* st) {
    XcdBarrier b; b.bar = bar; b.x = xb_xcc_id(); b.st = st;
    if (threadIdx.x == 0) (void)xb_add(&bar[XB_XCNT(b.x)], 1u);
    return b;
}
__device__ __forceinline__ void xcd_barrier_complete(unsigned* bar, unsigned x, unsigned& nloc, unsigned& nx) {
    const unsigned G = gridDim.x * gridDim.y * gridDim.z;
    unsigned sum, cnt, mine, sp = 0u;
    for (;;) {
        sum = 0u; cnt = 0u; mine = 0u;
#pragma unroll
        for (unsigned j = 0; j < 16; ++j) { const unsigned c = xb_ld(&bar[XB_XCNT(j)]); sum += c; cnt += (c > 0u) ? 1u : 0u; mine = (j == x) ? c : mine; }
        if (sum == G) break;
        __builtin_amdgcn_s_sleep(1);
        if ((++sp & 255u) == 0u) { if (xb_ld(&bar[XB_TMO])) break; if (sp > XB_SPIN_CAP) { atomicAdd(&bar[XB_TMO], 1u); break; } }
    }
    nloc = mine > 0u ? mine : 1u; nx = cnt > 0u ? cnt : 1u;
}

__device__ __forceinline__ void xcd_barrier(const XcdBarrier& b) {
    asm volatile("s_waitcnt vmcnt(0)" ::: "memory");
    __syncthreads();
    if (threadIdx.x == 0) {
        unsigned* bar = b.bar;
        __builtin_amdgcn_s_waitcnt(0);
        unsigned nloc = b.st[0], nx = b.st[1];
        if (nloc == 0u) { xcd_barrier_complete(bar, b.x, nloc, nx); b.st[0] = nloc; b.st[1] = nx; }
        const unsigned old = xb_add(&bar[XB_XSUB(b.x)], 1u);
        const unsigned gen = old / nloc;
        if (old + 1u == (gen + 1u) * nloc) {
            __builtin_amdgcn_fence(__ATOMIC_RELEASE, "agent");
            asm volatile("s_waitcnt vmcnt(0)" ::: "memory");
            const unsigned og = xb_add(&bar[XB_TOP], 1u);
            const unsigned tg = og / nx;
            if (og + 1u == (tg + 1u) * nx) xb_add(&bar[XB_TOPGEN], 1u);
            else XB_SPIN(xb_ld(&bar[XB_TOPGEN]) == tg, bar);
            __builtin_amdgcn_fence(__ATOMIC_ACQUIRE, "agent");
            xb_add(&bar[XB_XGEN(b.x)], 1u);
            asm volatile("s_waitcnt vmcnt(0)" ::: "memory");
        } else {
            XB_SPIN(xb_ld(&bar[XB_XGEN(b.x)]) == gen, bar);
            __builtin_amdgcn_fence(__ATOMIC_ACQUIRE, "agent");
            asm volatile("s_waitcnt vmcnt(0)" ::: "memory");
        }
    }
    __syncthreads();
}
#ifndef ROUTER_MFMA
#define ROUTER_MFMA 1
#endif
#ifndef P5_PAIR
#define P5_PAIR 1
#endif

constexpr int SEQ = 16384, DM = 1024, NPROJ = 5632, INCOLS = 5640, NMEM = 256, NEXP = 32;
constexpr int NWAVES = 8, NTHR = 512;
constexpr float EPS = 1e-6f;
constexpr int PC_QA = 0, PC_KA = 512, PC_VA = 1024, PC_QB = 1536, PC_ZB = 3072, PC_GA = 3584, PC_GB = 4608;
constexpr size_t MiB = 1u << 20;
constexpr size_t WS_CTL = 0, CTL_ZERO_BYTES = 1 * MiB;
constexpr size_t WS_WT_IN = 2 * MiB, WS_WT_UPA = 14 * MiB, WS_WT_UPB = 15 * MiB, WS_WT_OUT = 16 * MiB, WS_WT_QX = 18 * MiB, WS_WT_KV = 20 * MiB, WS_WT_OX = 24 * MiB;
constexpr size_t WS_W1T = 32 * MiB, WS_W2T = 160 * MiB, WS_H = 224 * MiB, WS_PROJ = 256 * MiB;
constexpr size_t WS_OA = 432 * MiB, WS_OB = 448 * MiB, WS_MRG = 464 * MiB, WS_X1 = 496 * MiB, WS_X2 = 560 * MiB, WS_QX = 624 * MiB, WS_OX = 656 * MiB;
constexpr size_t WS_KVX = 688 * MiB, WS_MEMN = 689 * MiB, WS_GG = 690 * MiB, WS_GBETA = 690 * MiB + 512 * 1024, WS_GQKV = 692 * MiB, WS_GO = 780 * MiB;
constexpr size_t WS_TOPE = 772 * MiB, WS_TOPW = 772 * MiB + 256 * 1024, WS_SPOS = 772 * MiB + 512 * 1024, WS_SLOTW = 773 * MiB;
constexpr size_t WS_VIMG = 800 * MiB;
constexpr size_t WS_H8 = 808 * MiB, WS_WT_IN8 = 824 * MiB;
constexpr size_t WS_WRH = 828 * MiB, WS_WRL = 828 * MiB + 65536;
constexpr size_t WS_XS = 776 * MiB, WS_ACT = 256 * MiB, WS_YS = 400 * MiB, WS_END = 1024 * MiB;
constexpr int CW_SCAN = 3600;
constexpr int CW_BAR = 4096, CW_CNT = 16384;
constexpr int RING_BYTES = 131072, EXTRA_OFF = 131072, MISC_OFF = 139264, LDS_BYTES = 147456;
constexpr int NPH = 15;

struct Args { const float* in[30]; float* out; unsigned char* ws; int ph_lo, ph_hi; };

#define WSP(T, off) ((T*)(a.ws + (off)))

#ifndef MOE_F8
#define MOE_F8 1
#endif
#ifndef FP8_X
#define FP8_X 1
#endif
#ifndef PV_F8
#define PV_F8 1
#endif
#ifndef GATE_F8
#define GATE_F8 1
#endif
#ifndef FP8_IN
#define FP8_IN 0
#endif
constexpr float W8_SCALE = 32.f;
__device__ __forceinline__ unsigned pk4_fp8(float a, float b, float c, float d) { int w = 0; w = __builtin_amdgcn_cvt_pk_fp8_f32(a, b, w, false); w = __builtin_amdgcn_cvt_pk_fp8_f32(c, d, w, true); return (unsigned)w; }
template <bool F8 = false>
__device__ __forceinline__ void tr_item(const float* __restrict__ W, int ldw, int col0, bf16* WT, int ldk, size_t drow0, int dk0, int k0, LAS float* scr, int lane, const float* kscale = nullptr) {
    const int c4 = (lane & 15) * 4, r4 = lane >> 4;
    f32x4 v[16];
#pragma unroll
    for (int i = 0; i < 16; ++i) v[i] = __builtin_nontemporal_load((const f32x4*)(W + (size_t)(k0 + r4 + 4 * i) * ldw + col0 + c4));
    if (kscale) {
#pragma unroll
        for (int i = 0; i < 16; ++i) v[i] = v[i] * kscale[k0 + r4 + 4 * i]; }
#pragma unroll
    for (int i = 0; i < 16; ++i) { LAS float* s = scr + (r4 + 4 * i) * 65 + c4; s[0] = v[i].x; s[1] = v[i].y; s[2] = v[i].z; s[3] = v[i].w; }
    LDS_WAIT(); asm volatile("" ::: "memory");
    const int c = lane & 7;
#pragma unroll
    for (int j = 0; j < 8; ++j) { const int n = (lane >> 3) + 8 * j; const LAS float* s = scr + (8 * c) * 65 + n;
        if (F8) { v2u o; o.x = pk4_fp8(s[0] * W8_SCALE, s[65] * W8_SCALE, s[130] * W8_SCALE, s[195] * W8_SCALE); o.y = pk4_fp8(s[260] * W8_SCALE, s[325] * W8_SCALE, s[390] * W8_SCALE, s[455] * W8_SCALE);
            *(v2u*)((unsigned char*)WT + (drow0 + n) * (size_t)ldk + dk0 + k0 + 8 * c) = o; }
        else { v4u o; o.x = pk2(s[0], s[65]); o.y = pk2(s[130], s[195]); o.z = pk2(s[260], s[325]); o.w = pk2(s[390], s[455]);
            *(v4u*)(WT + (drow0 + n) * (size_t)ldk + dk0 + k0 + 8 * c) = o; } }
    LDS_WAIT(); asm volatile("" ::: "memory");
}
__device__ __forceinline__ float rms_row_load(const float* xrow, const float* g, int lane, f32x4 (&v)[4]) {
    const f32x4* xr = (const f32x4*)xrow + lane; float s = 0.f;
#pragma unroll
    for (int j = 0; j < 4; ++j) { v[j] = xr[64 * j]; s += (v[j].x * v[j].x + v[j].y * v[j].y) + (v[j].z * v[j].z + v[j].w * v[j].w); }
    const float rstd = rsqrtf(wave_sum(s) * (1.f / DM) + EPS);
#pragma unroll
    for (int j = 0; j < 4; ++j) { const f32x4 gv = ((const f32x4*)g)[lane + 64 * j]; v[j] = v[j] * rstd * gv; }
    return rstd;
}
__device__ __forceinline__ float rms_row_load_bf16(const bf16* xrow, const float* g, int lane, f32x4 (&v)[4]) {
    const v2u* xr = (const v2u*)xrow + lane; float s = 0.f;
#pragma unroll
    for (int j = 0; j < 4; ++j) { const v2u r = xr[64 * j]; v[j] = (f32x4){bflo(r.x), bfhi(r.x), bflo(r.y), bfhi(r.y)}; s += (v[j].x * v[j].x + v[j].y * v[j].y) + (v[j].z * v[j].z + v[j].w * v[j].w); }
    const float rstd = rsqrtf(wave_sum(s) * (1.f / DM) + EPS);
#pragma unroll
    for (int j = 0; j < 4; ++j) { const f32x4 gv = ((const f32x4*)g)[lane + 64 * j]; v[j] = v[j] * rstd * gv; }
    return rstd;
}
__device__ __forceinline__ void row_store_bf16(bf16* orow, int lane, const f32x4 (&v)[4]) {
    unsigned long long* o8 = (unsigned long long*)orow + lane;
#pragma unroll
    for (int j = 0; j < 4; ++j) o8[64 * j] = (unsigned long long)pk2(v[j].x, v[j].y) | ((unsigned long long)pk2(v[j].z, v[j].w) << 32);
}
__device__ __forceinline__ void rms_rows_bf16(const float* X, const float* g, bf16* O, int nrows, int gw, int NGW, int lane) {
    for (int t = gw; t < nrows; t += NGW) { f32x4 v[4]; rms_row_load(X + (size_t)t * DM, g, lane, v); row_store_bf16(O + (size_t)t * DM, lane, v); }
}
constexpr int ITEMS_MOE = 32 * 512 + 32 * 256;
__device__ __forceinline__ void prep_items(const Args& a, LAS float* scr, int lane, int first, int stride, int limit = 0x7fffffff) {
    constexpr int I7 = 32 * 512, I8 = 32 * 256, I0 = 16 * 88, I1 = 128, I2 = 128, I3 = 256, I4 = 256, I5 = 512, I6 = 256;
    constexpr int NITEMS = I7 + I8 + I0 + I1 + I2 + I3 + I4 + I5 + I6;
    const int end = limit < NITEMS ? limit : NITEMS;
    for (int it = first; it < end; it += stride) { int r = it;
        if (r < I7) { const int e = r >> 9, q = r & 511, kb = q >> 5, n0 = (q & 31) * 64, j = n0 >> 8, rr = n0 & 255, col0 = rr < 128 ? 128 * j + rr : 1024 + 128 * j + rr - 128;
            tr_item<MOE_F8 != 0>(a.in[25] + (size_t)e * 1024 * 2048, 2048, col0, WSP(bf16, WS_W1T), 1024, (size_t)e * 2048 + n0, 0, kb * 64, scr, lane, a.in[22]); continue; } r -= I7;
        if (r < I8) { const int e = r >> 8, q = r & 255, kb = q >> 4, n0 = (q & 15) * 64;
            tr_item<MOE_F8 != 0>(a.in[27] + (size_t)e * 1024 * 1024, 1024, n0, WSP(bf16, WS_W2T), 1024, (size_t)e * 1024 + n0, 0, kb * 64, scr, lane); continue; } r -= I8;
        if (r < I0) { const int kb = r / 88, n0 = (r % 88) * 64, col0 = n0 < 3584 ? n0 : n0 + 8;
            if (GATE_F8 && n0 >= 3072) tr_item<true>(a.in[3], INCOLS, col0, WSP(bf16, WS_WT_IN8), 1024, n0 - 3072, 0, kb * 64, scr, lane);
            else tr_item<FP8_IN != 0>(a.in[3], INCOLS, col0, WSP(bf16, WS_WT_IN), 1024, n0, 0, kb * 64, scr, lane);
            continue; } r -= I0;
        if (r < I1) { tr_item(a.in[14], 1024, (r & 15) * 64, WSP(bf16, WS_WT_UPA), 512, (r & 15) * 64, 0, (r >> 4) * 64, scr, lane); continue; } r -= I1;
        if (r < I2) { tr_item(a.in[15], 1024, (r & 15) * 64, WSP(bf16, WS_WT_UPB), 512, (r & 15) * 64, 0, (r >> 4) * 64, scr, lane); continue; } r -= I2;
        if (r < I3) { tr_item(a.in[16], 1024, (r & 15) * 64, WSP(bf16, WS_WT_OUT), 1024, (r & 15) * 64, 0, (r >> 4) * 64, scr, lane); continue; } r -= I3;
        if (r < I4) { tr_item<FP8_X != 0>(a.in[19], 1024, (r & 15) * 64, WSP(bf16, WS_WT_QX), 1024, (r & 15) * 64, 0, (r >> 4) * 64, scr, lane, a.in[17]); continue; } r -= I4;
        if (r < I5) { tr_item(a.in[20], 2048, (r & 31) * 64, WSP(bf16, WS_WT_KV), 1024, (r & 31) * 64, 0, (r >> 5) * 64, scr, lane); continue; } r -= I5;
        tr_item<FP8_X != 0>(a.in[21], 1024, (r & 15) * 64, WSP(bf16, WS_WT_OX), 1024, (r & 15) * 64, 0, (r >> 4) * 64, scr, lane);
    }
}

struct MoeIt { const float* src; size_t ldw; unsigned char* dst; const float* ks; int k0; };
__device__ __forceinline__ MoeIt moe_item(const Args& a, int r, int lane) {
    constexpr int I7 = 32 * 512;
    const int c4 = (lane & 15) * 4, r4 = lane >> 4; MoeIt m;
    if (r < I7) { const int e = r >> 9, q = r & 511, kb = q >> 5, n0 = (q & 31) * 64, j = n0 >> 8, rr = n0 & 255, col0 = rr < 128 ? 128 * j + rr : 1024 + 128 * j + rr - 128;
        m.k0 = kb * 64; m.ldw = 2048; m.src = a.in[25] + (size_t)e * 1024 * 2048 + (size_t)(m.k0 + r4) * 2048 + col0 + c4; m.ks = a.in[22];
        m.dst = (unsigned char*)WSP(bf16, WS_W1T) + ((size_t)e * 2048 + n0) * (MOE_F8 ? 1024 : 2048) + (size_t)m.k0 * (MOE_F8 ? 1 : 2); }
    else { r -= I7; const int e = r >> 8, q = r & 255, kb = q >> 4, n0 = (q & 15) * 64;
        m.k0 = kb * 64; m.ldw = 1024; m.src = a.in[27] + (size_t)e * 1024 * 1024 + (size_t)(m.k0 + r4) * 1024 + n0 + c4; m.ks = nullptr;
        m.dst = (unsigned char*)WSP(bf16, WS_W2T) + ((size_t)e * 1024 + n0) * (MOE_F8 ? 1024 : 2048) + (size_t)m.k0 * (MOE_F8 ? 1 : 2); }
    return m;
}
#define MOE_LOAD(V, M) do { _Pragma("unroll") for (int i = 0; i < 16; ++i) V[i] = __builtin_nontemporal_load((const f32x4*)((M).src + (size_t)(4 * i) * (M).ldw)); } while (0)
__device__ __forceinline__ void moe_process(f32x4 (&v)[16], const MoeIt& m, LAS float* scr, int lane) {
    const int c4 = (lane & 15) * 4, r4 = lane >> 4;
    if (m.ks) {
#pragma unroll
        for (int i = 0; i < 16; ++i) v[i] = v[i] * m.ks[m.k0 + r4 + 4 * i]; }
#pragma unroll
    for (int i = 0; i < 16; ++i) { LAS float* s = scr + (r4 + 4 * i) * 65 + c4; s[0] = v[i].x; s[1] = v[i].y; s[2] = v[i].z; s[3] = v[i].w; }
    LDS_WAIT(); asm volatile("" ::: "memory");
    const int c = lane & 7;
#pragma unroll
    for (int j = 0; j < 8; ++j) { const int n = (lane >> 3) + 8 * j; const LAS float* s = scr + (8 * c) * 65 + n;
        if (MOE_F8) { v2u o; o.x = pk4_fp8(s[0] * W8_SCALE, s[65] * W8_SCALE, s[130] * W8_SCALE, s[195] * W8_SCALE); o.y = pk4_fp8(s[260] * W8_SCALE, s[325] * W8_SCALE, s[390] * W8_SCALE, s[455] * W8_SCALE);
            *(v2u*)(m.dst + (size_t)n * 1024 + 8 * c) = o; }
        else { v4u o; o.x = pk2(s[0], s[65]); o.y = pk2(s[130], s[195]); o.z = pk2(s[260], s[325]); o.w = pk2(s[390], s[455]);
            *(v4u*)(m.dst + (size_t)n * 2048 + 16 * c) = o; } }
    LDS_WAIT(); asm volatile("" ::: "memory");
}
__device__ __forceinline__ void prep_moe_pf(const Args& a, LAS float* scr, int lane, int first, int stride) {
    f32x4 va[16], vb[16];
    int it = first;
    if (it >= ITEMS_MOE) return;
    MoeIt ma = moe_item(a, it, lane), mb = ma;
    MOE_LOAD(va, ma);
    while (true) {
        int nx = it + stride;
        if (nx < ITEMS_MOE) { mb = moe_item(a, nx, lane); MOE_LOAD(vb, mb); }
        moe_process(va, ma, scr, lane);
        it = nx; if (it >= ITEMS_MOE) break;
        nx = it + stride;
        if (nx < ITEMS_MOE) { ma = moe_item(a, nx, lane); MOE_LOAD(va, ma); }
        moe_process(vb, mb, scr, lane);
        it = nx; if (it >= ITEMS_MOE) break;
    }
}
__device__ __forceinline__ void phase_prep(const Args& a, LAS unsigned char* lds, int tid, int lane, int wave, int G, int bid) {
    LAS float* scr = (LAS float*)(lds + wave * 16640);
    LAS float* wab = (LAS float*)(lds + 81920);
    const int gw = bid * NWAVES + wave, NGW = G * NWAVES;
    for (int i = tid; i < 8192; i += NTHR) { const int k = i >> 3, c = i & 7; wab[c * 1024 + k] = a.in[3][(size_t)k * INCOLS + 3584 + c]; }
    __syncthreads();
    bf16* H = WSP(bf16, WS_H); float* GG = WSP(float, WS_GG); float* GB = WSP(float, WS_GBETA);
    for (int t = gw; t < SEQ; t += NGW) {
        f32x4 v[4]; float red[9];
        { const f32x4* xr = (const f32x4*)(a.in[0] + (size_t)t * DM) + lane; float s = 0.f;
#pragma unroll
          for (int j = 0; j < 4; ++j) { const f32x4 xv = xr[64 * j]; s += (xv.x * xv.x + xv.y * xv.y) + (xv.z * xv.z + xv.w * xv.w); v[j] = xv * ((const f32x4*)a.in[2])[lane + 64 * j]; }
          red[8] = s; }
#pragma unroll
        for (int c = 0; c < 8; ++c) { float p = 0.f;
#pragma unroll
            for (int j = 0; j < 4; ++j) { const f32x4 w = *(const LAS f32x4*)(wab + c * 1024 + 256 * j + 4 * lane); p += (v[j].x * w.x + v[j].y * w.y) + (v[j].z * w.z + v[j].w * w.w); }
            red[c] = p; }
#pragma unroll
        for (int o = 1; o < 64; o <<= 1)
#pragma unroll
            for (int c = 0; c < 9; ++c) red[c] += __shfl_xor(red[c], o);
        const float rstd = rsqrtf(red[8] * (1.f / DM) + EPS);
#pragma unroll
        for (int j = 0; j < 4; ++j) v[j] = v[j] * rstd;
        if (FP8_IN) {
#pragma unroll
            for (int j = 0; j < 4; ++j) ((unsigned*)((unsigned char*)H + (size_t)t * DM))[lane + 64 * j] = pk4_fp8(v[j].x, v[j].y, v[j].z, v[j].w); }
        else row_store_bf16(H + (size_t)t * DM, lane, v);
        if (GATE_F8) {
#pragma unroll
            for (int j = 0; j < 4; ++j) ((unsigned*)(a.ws + WS_H8 + (size_t)t * DM))[lane + 64 * j] = pk4_fp8(v[j].x, v[j].y, v[j].z, v[j].w); }
        float mine = 0.f;
#pragma unroll
        for (int c = 0; c < 8; ++c) if (lane == c) mine = red[c] * rstd;
        if (lane < 4) { const float xx = mine + a.in[12][lane]; const float sp = xx > 20.f ? xx : log1pf(expf(xx)); GG[t * 4 + lane] = -expf(a.in[11][lane]) * sp; }
        else if (lane < 8) GB[t * 4 + lane - 4] = 1.f / (1.f + expf(-mine));
    }
    rms_rows_bf16(a.in[1], a.in[18], WSP(bf16, WS_MEMN), NMEM, gw, NGW, lane);
    __syncthreads();
    prep_items(a, scr, lane, ITEMS_MOE + gw, NGW);
    if (ROUTER_MFMA) { bf16* WRH = WSP(bf16, WS_WRH); bf16* WRL = WSP(bf16, WS_WRL);
        for (int i = gw * 64 + lane; i < 32768; i += NGW * 64) { const int k = i >> 5, e = i & 31; const float w = a.in[22][k] * a.in[23][i];
            const unsigned hb = f2bf(w); const float hf = __builtin_bit_cast(float, hb << 16); WRH[e * 1024 + k] = (bf16)hb; WRL[e * 1024 + k] = (bf16)f2bf(w - hf); } }
}

__device__ __forceinline__ void phase_gdn_prep(const Args& a, int lane, int gw, int NGW) {
    const float* cw = a.in[10];
    const bf16* PROJ = WSP(const bf16, WS_PROJ); bf16* GQKV = WSP(bf16, WS_GQKV);
    float w[3][4][8];
#pragma unroll
    for (int p = 0; p < 3; ++p)
#pragma unroll
        for (int j = 0; j < 4; ++j)
#pragma unroll
            for (int i = 0; i < 8; ++i) w[p][j][i] = cw[j * 1536 + 512 * p + 8 * lane + i];
    for (int t = gw; t < SEQ; t += NGW) {
#pragma unroll
        for (int p = 0; p < 3; ++p) {
            float acc[8];
#pragma unroll
            for (int i = 0; i < 8; ++i) acc[i] = 0.f;
#pragma unroll
            for (int j = 0; j < 4; ++j) { const int tt = t - 3 + j;
                if (tt >= 0) { const v4u raw = *(const v4u*)(PROJ + (size_t)tt * NPROJ + PC_QB + 512 * p + 8 * lane);
#pragma unroll
                    for (int i = 0; i < 4; ++i) { acc[2 * i] += w[p][j][2 * i] * bflo(raw[i]); acc[2 * i + 1] += w[p][j][2 * i + 1] * bfhi(raw[i]); } } }
            float ss = 0.f;
#pragma unroll
            for (int i = 0; i < 8; ++i) { acc[i] = siluf_(acc[i]); ss += acc[i] * acc[i]; }
            if (p < 2) { ss += __shfl_xor(ss, 1); ss += __shfl_xor(ss, 2); ss += __shfl_xor(ss, 4); ss += __shfl_xor(ss, 8);
                const float rn = rsqrtf(ss + EPS) * (p == 0 ? 0.08838834764831845f : 1.f);
#pragma unroll
                for (int i = 0; i < 8; ++i) acc[i] *= rn; }
            v4u o; o.x = pk2(acc[0], acc[1]); o.y = pk2(acc[2], acc[3]); o.z = pk2(acc[4], acc[5]); o.w = pk2(acc[6], acc[7]);
            *(v4u*)(GQKV + (size_t)t * 1536 + 512 * p + 8 * lane) = o;
        }
    }
}

__device__ __forceinline__ int t5_bucket(int rel) {
    const int ret = rel > 0 ? 16 : 0; const int n = rel < 0 ? -rel : rel;
    int large = 8 + (int)(logf((float)(n < 1 ? 1 : n) / 8.f) / 2.772588722239781f * 8.f);
    large = large < 15 ? large : 15;
    return ret + (n < 8 ? n : large);
}
__device__ __forceinline__ void attn_simple_unit(const Args& a, unsigned char* ldsg, int tid, int h, int qt, float lam) {
    float* Ks = (float*)ldsg;
    float* Vs = Ks + 8192;
    float* EX = (float*)ldsg;
    float* TAB = (float*)(ldsg + EXTRA_OFF);
    float* SSQ = TAB + 320;
    const bf16* PROJ = WSP(const bf16, WS_PROJ); const float* relb = a.in[4];
    const int q = tid & 127, map = (tid >> 7) & 1, half = tid >> 8;
    const int qpos = qt * 128 + q, qchunk = qpos >> 6;
    __syncthreads();
    if (tid < 319) TAB[tid] = relb[t5_bucket(tid - 255) * 4 + h];
    const float farb = relb[15 * 4 + h];
    float qv[64], acc[64];
    { const v4u* qp = (const v4u*)(PROJ + (size_t)qpos * NPROJ + PC_QA + h * 128 + map * 64);
#pragma unroll
      for (int i = 0; i < 8; ++i) { const v4u r = qp[i];
#pragma unroll
          for (int w = 0; w < 4; ++w) { qv[8 * i + 2 * w] = bflo(r[w]) * 0.125f; qv[8 * i + 2 * w + 1] = bfhi(r[w]) * 0.125f; } } }
#pragma unroll
    for (int d = 0; d < 64; ++d) acc[d] = 0.f;
    float m = -INFINITY, l = 0.f;
    const int nkt = 2 * qt + 2;
    for (int kt = 0; kt < nkt; ++kt) {
        __syncthreads();
        { const int key = tid >> 3, seg = tid & 7; const size_t row = (size_t)(kt * 64 + key) * NPROJ;
          const v4u* kp = (const v4u*)(PROJ + row + PC_KA + h * 128 + seg * 16); const v4u r0 = kp[0], r1 = kp[1];
          float* kd = Ks + ((seg >> 2) * 64 + key) * 64 + (seg & 3) * 16;
#pragma unroll
          for (int w = 0; w < 4; ++w) { kd[2 * w] = bflo(r0[w]); kd[2 * w + 1] = bfhi(r0[w]); kd[8 + 2 * w] = bflo(r1[w]); kd[8 + 2 * w + 1] = bfhi(r1[w]); }
          const v4u* vp = (const v4u*)(PROJ + row + PC_VA + h * 128 + seg * 16); const v4u s0 = vp[0], s1 = vp[1];
          float* vd = Vs + key * 128 + seg * 16;
#pragma unroll
          for (int w = 0; w < 4; ++w) { vd[2 * w] = bflo(s0[w]); vd[2 * w + 1] = bfhi(s0[w]); vd[8 + 2 * w] = bflo(s1[w]); vd[8 + 2 * w + 1] = bfhi(s1[w]); } }
        __syncthreads();
        if (kt <= qchunk) {
            const float* Kb = Ks + map * 4096;
#pragma unroll 1
            for (int j = 0; j < 64; ++j) {
                const f32x4* kr = (const f32x4*)(Kb + j * 64);
                float s = 0.f;
#pragma unroll
                for (int i = 0; i < 16; ++i) { const f32x4 k4 = kr[i]; s += (qv[4 * i] * k4.x + qv[4 * i + 1] * k4.y) + (qv[4 * i + 2] * k4.z + qv[4 * i + 3] * k4.w); if ((i & 3) == 3) asm volatile("" ::: "memory"); }
                const int rel = kt * 64 + j - qpos; s += rel < -255 ? farb : TAB[rel + 255];
                if (s > m) { const float f = __expf(m - s); l *= f;
#pragma unroll
                    for (int d = 0; d < 64; ++d) acc[d] *= f;
                    m = s; }
                const float p = __expf(s - m); l += p;
                const f32x4* vr = (const f32x4*)(Vs + j * 128 + half * 64);
#pragma unroll
                for (int i = 0; i < 16; ++i) { const f32x4 v4 = vr[i]; acc[4 * i] += p * v4.x; acc[4 * i + 1] += p * v4.y; acc[4 * i + 2] += p * v4.z; acc[4 * i + 3] += p * v4.w; if ((i & 3) == 3) asm volatile("" ::: "memory"); }
            }
        }
    }
    __syncthreads();
    const float inv = 1.f / l;
    if (map == 1) {
#pragma unroll
        for (int d = 0; d < 64; ++d) EX[q * 129 + half * 64 + d] = acc[d] * inv; }
    __syncthreads();
    if (map == 0) { float ss = 0.f;
#pragma unroll
        for (int d = 0; d < 64; ++d) { acc[d] = acc[d] * inv - lam * EX[q * 129 + half * 64 + d]; ss += acc[d] * acc[d]; }
        SSQ[q * 2 + half] = ss; }
    __syncthreads();
    if (map == 0) { const float r = rsqrtf((SSQ[q * 2] + SSQ[q * 2 + 1]) * (1.f / 128.f) + EPS) * 0.8f; const float* gs = a.in[9] + half * 64;
        bf16* op = WSP(bf16, WS_OA) + (size_t)qpos * 512 + h * 128 + half * 64;
#pragma unroll
        for (int i = 0; i < 8; ++i) { v4u o;
            o.x = pk2(acc[8 * i] * r * gs[8 * i], acc[8 * i + 1] * r * gs[8 * i + 1]); o.y = pk2(acc[8 * i + 2] * r * gs[8 * i + 2], acc[8 * i + 3] * r * gs[8 * i + 3]);
            o.z = pk2(acc[8 * i + 4] * r * gs[8 * i + 4], acc[8 * i + 5] * r * gs[8 * i + 5]); o.w = pk2(acc[8 * i + 6] * r * gs[8 * i + 6], acc[8 * i + 7] * r * gs[8 * i + 7]);
            *(v4u*)(op + 8 * i) = o; } }
}
__device__ __forceinline__ void gdn_scan_simple(const Args& a, unsigned char* ldsg, int tid, int h) {
    float* qs = (float*)ldsg; float* ks = qs + 8192; float* vs = ks + 8192;
    float* red = vs + 8192;
    float* gs = (float*)(ldsg + EXTRA_OFF); float* bs = gs + 64;
    const bf16* GQKV = WSP(const bf16, WS_GQKV); const float* GG = WSP(const float, WS_GG); const float* GB = WSP(const float, WS_GBETA); float* GO = WSP(float, WS_GO);
    const int e = tid & 127, dq = tid >> 7;
    float S[32];
#pragma unroll
    for (int d = 0; d < 32; ++d) S[d] = 0.f;
    for (int n = 0; n < 256; ++n) {
        __syncthreads();
        { const int row = tid >> 3, seg = tid & 7; const size_t t = (size_t)n * 64 + row;
#pragma unroll
          for (int p = 0; p < 3; ++p) { const v4u* sp = (const v4u*)(GQKV + t * 1536 + 512 * p + h * 128 + seg * 16); const v4u r0 = sp[0], r1 = sp[1];
              float* dp = (p == 0 ? qs : p == 1 ? ks : vs) + row * 128 + seg * 16;
#pragma unroll
              for (int w = 0; w < 4; ++w) { dp[2 * w] = bflo(r0[w]); dp[2 * w + 1] = bfhi(r0[w]); dp[8 + 2 * w] = bflo(r1[w]); dp[8 + 2 * w + 1] = bfhi(r1[w]); } } }
        if (tid < 64) { gs[tid] = GG[(n * 64 + tid) * 4 + h]; bs[tid] = GB[(n * 64 + tid) * 4 + h]; }
        __syncthreads();
#pragma unroll 1
        for (int i = 0; i < 64; ++i) {
            const float al = expf(gs[i]), be = bs[i];
            const f32x4* kr = (const f32x4*)(ks + i * 128 + dq * 32); const f32x4* qr = (const f32x4*)(qs + i * 128 + dq * 32);
            float kS = 0.f;
#pragma unroll
            for (int d4 = 0; d4 < 8; ++d4) { const f32x4 k4 = kr[d4];
                S[4 * d4] *= al; S[4 * d4 + 1] *= al; S[4 * d4 + 2] *= al; S[4 * d4 + 3] *= al;
                kS += (k4.x * S[4 * d4] + k4.y * S[4 * d4 + 1]) + (k4.z * S[4 * d4 + 2] + k4.w * S[4 * d4 + 3]); }
            red[dq * 128 + e] = kS;
            __syncthreads();
            const float kSt = (red[e] + red[128 + e]) + (red[256 + e] + red[384 + e]);
            const float vn = be * (vs[i * 128 + e] - kSt);
            float o = 0.f;
#pragma unroll
            for (int d4 = 0; d4 < 8; ++d4) { const f32x4 k4 = kr[d4]; const f32x4 q4 = qr[d4];
                S[4 * d4] += k4.x * vn; S[4 * d4 + 1] += k4.y * vn; S[4 * d4 + 2] += k4.z * vn; S[4 * d4 + 3] += k4.w * vn;
                o += (q4.x * S[4 * d4] + q4.y * S[4 * d4 + 1]) + (q4.z * S[4 * d4 + 2] + q4.w * S[4 * d4 + 3]); }
            red[512 + dq * 128 + e] = o;
            __syncthreads();
            if (dq == 0) GO[(size_t)(n * 64 + i) * 512 + h * 128 + e] = (red[512 + e] + red[640 + e]) + (red[768 + e] + red[896 + e]);
        }
    }
}
__device__ __forceinline__ void phase_mixers_simple(const Args& a, unsigned char* ldsg, int tid, int G, int bid) {
#ifndef NO_SCAN
    if (bid >= G - 4) { gdn_scan_simple(a, ldsg, tid, bid - (G - 4)); return; }
#endif
#ifndef NO_ATTN
    float s1 = 0.f, s2 = 0.f;
    for (int i = 0; i < 64; ++i) { s1 += a.in[5][i] * a.in[6][i]; s2 += a.in[7][i] * a.in[8][i]; }
    const float lam = expf(s1) - expf(s2) + 0.2f;
    for (int u = bid; u < 512; u += G - 4) attn_simple_unit(a, ldsg, tid, u & 3, 127 - (u >> 2), lam);
#endif
}

__device__ __forceinline__ void phase_gdn_post(const Args& a, int lane, int gw, int NGW, int t_lo = 0, int t_hi = SEQ) {
    const bf16* GO = WSP(const bf16, WS_GO); const bf16* PROJ = WSP(const bf16, WS_PROJ); bf16* OB = WSP(bf16, WS_OB); const float* gb = a.in[13];
    for (int t = t_lo + gw; t < t_hi; t += NGW) {
        const v4u ov = *(const v4u*)(GO + (size_t)t * 512 + 8 * lane); const f32x4 o0 = {bflo(ov.x), bfhi(ov.x), bflo(ov.y), bfhi(ov.y)}, o1 = {bflo(ov.z), bfhi(ov.z), bflo(ov.w), bfhi(ov.w)};
        float ss = (o0.x * o0.x + o0.y * o0.y) + (o0.z * o0.z + o0.w * o0.w) + (o1.x * o1.x + o1.y * o1.y) + (o1.z * o1.z + o1.w * o1.w);
        ss += __shfl_xor(ss, 1); ss += __shfl_xor(ss, 2); ss += __shfl_xor(ss, 4); ss += __shfl_xor(ss, 8);
        const float r = rsqrtf(ss * (1.f / 128.f) + EPS);
        const v4u z = *(const v4u*)(PROJ + (size_t)t * NPROJ + PC_ZB + 8 * lane);
        const f32x4* gp = (const f32x4*)(gb + ((8 * lane) & 127)); const f32x4 g0 = gp[0], g1 = gp[1];
        v4u o;
        o.x = pk2(o0.x * r * g0.x * siluf_(bflo(z.x)), o0.y * r * g0.y * siluf_(bfhi(z.x))); o.y = pk2(o0.z * r * g0.z * siluf_(bflo(z.y)), o0.w * r * g0.w * siluf_(bfhi(z.y)));
        o.z = pk2(o1.x * r * g1.x * siluf_(bflo(z.z)), o1.y * r * g1.y * siluf_(bfhi(z.z))); o.w = pk2(o1.z * r * g1.z * siluf_(bflo(z.w)), o1.w * r * g1.w * siluf_(bfhi(z.w)));
        *(v4u*)(OB + (size_t)t * 512 + 8 * lane) = o;
    }
}

template <bool SECOND> struct EpiGate {
    static constexpr bool PERM = true, AFTER_DRAIN = false;
    const bf16* proj; bf16* mrg;
    __device__ __forceinline__ void operator()(const pg8::f32x4 (&acc)[2][2][4][2], const pg8::Unit& u, int wr, int wc, int fr, int fq) const {
        const int row0 = u.pm * 256 + wr * 64 + fr, col0 = u.pn * 256 + wc * 32 + 8 * fq;
#pragma unroll
        for (int ai = 0; ai < 2; ++ai) {
            v4u gr[4][2], pr[4][2];
#pragma unroll
            for (int m = 0; m < 4; ++m)
#pragma unroll
                for (int bj = 0; bj < 2; ++bj) { const size_t row = (size_t)(row0 + ai * 128 + m * 16); const int col = col0 + bj * 128;
                    gr[m][bj] = *(const v4u*)(proj + row * NPROJ + (SECOND ? PC_GB : PC_GA) + col);
                    if (SECOND) pr[m][bj] = *(const v4u*)(mrg + row * DM + col); }
#pragma unroll
            for (int m = 0; m < 4; ++m) { asm volatile("" : "+v"(gr[m][0]), "+v"(gr[m][1])); if (SECOND) asm volatile("" : "+v"(pr[m][0]), "+v"(pr[m][1])); }
#pragma unroll
            for (int m = 0; m < 4; ++m) { const size_t row = (size_t)(row0 + ai * 128 + m * 16);
#pragma unroll
                for (int bj = 0; bj < 2; ++bj) { const int col = col0 + bj * 128; const v4u g = gr[m][bj];
                    pg8::f32x4 v0 = acc[ai][bj][m][0], v1 = acc[ai][bj][m][1];
                    v0[0] *= bflo(g.x); v0[1] *= bfhi(g.x); v0[2] *= bflo(g.y); v0[3] *= bfhi(g.y);
                    v1[0] *= bflo(g.z); v1[1] *= bfhi(g.z); v1[2] *= bflo(g.w); v1[3] *= bfhi(g.w);
                    if (SECOND) { const v4u q = pr[m][bj];
                        v0[0] += bflo(q.x); v0[1] += bfhi(q.x); v0[2] += bflo(q.y); v0[3] += bfhi(q.y); v1[0] += bflo(q.z); v1[1] += bfhi(q.z); v1[2] += bflo(q.w); v1[3] += bfhi(q.w); }
                    v4u o; o.x = pg8::cvt_pk_bf16(v0[0], v0[1]); o.y = pg8::cvt_pk_bf16(v0[2], v0[3]); o.z = pg8::cvt_pk_bf16(v1[0], v1[1]); o.w = pg8::cvt_pk_bf16(v1[2], v1[3]);
                    *(v4u*)(mrg + row * DM + col) = o; } } }
    }
};
struct PairOrder { pg8::StaticOrder S;
    __device__ __forceinline__ bool next(int i, pg8::Unit& u) const { pg8::Unit b; if (!S.next(i >> 1, b)) return false; const int h = i & 1; u.pm = b.pm + 64 * h; u.pn = b.pn + 4 * h; return true; }
    __device__ __forceinline__ void a_ready(const pg8::Unit&) const {}
    __device__ __forceinline__ void done(const pg8::Unit&) const {}
};
struct EpiGatePair {
    static constexpr bool PERM = true, AFTER_DRAIN = false, PAIRED = true;
    const bf16* proj; bf16* mrg;
    static __device__ __forceinline__ bool keep(const pg8::Unit& u) { return u.pn < 4; }
    __device__ __forceinline__ void first(pg8::f32x4 (&acc)[2][2][4][2], const pg8::Unit& u, int wr, int wc, int fr, int fq) const {
        const int row0 = u.pm * 256 + wr * 64 + fr, col0 = u.pn * 256 + wc * 32 + 8 * fq;
#pragma unroll
        for (int ai = 0; ai < 2; ++ai) { v4u ga[4][2], gb[4][2];
#pragma unroll
            for (int m = 0; m < 4; ++m)
#pragma unroll
                for (int bj = 0; bj < 2; ++bj) { const bf16* pp = proj + (size_t)(row0 + ai * 128 + m * 16) * NPROJ + col0 + bj * 128; ga[m][bj] = *(const v4u*)(pp + PC_GA); gb[m][bj] = *(const v4u*)(pp + PC_GB); }
#pragma unroll
            for (int m = 0; m < 4; ++m)
#pragma unroll
                for (int bj = 0; bj < 2; ++bj) { const v4u x = ga[m][bj], y = gb[m][bj];
#define G2R(xa, yb) ((xa) * __builtin_amdgcn_rcpf(fmaxf((yb), 1e-30f)))
                    acc[ai][bj][m][0][0] *= G2R(bflo(x.x), bflo(y.x)); acc[ai][bj][m][0][1] *= G2R(bfhi(x.x), bfhi(y.x)); acc[ai][bj][m][0][2] *= G2R(bflo(x.y), bflo(y.y)); acc[ai][bj][m][0][3] *= G2R(bfhi(x.y), bfhi(y.y));
                    acc[ai][bj][m][1][0] *= G2R(bflo(x.z), bflo(y.z)); acc[ai][bj][m][1][1] *= G2R(bfhi(x.z), bfhi(y.z)); acc[ai][bj][m][1][2] *= G2R(bflo(x.w), bflo(y.w)); acc[ai][bj][m][1][3] *= G2R(bfhi(x.w), bfhi(y.w));
#undef G2R
                } }
    }
    __device__ __forceinline__ void operator()(const pg8::f32x4 (&acc)[2][2][4][2], const pg8::Unit& u, int wr, int wc, int fr, int fq) const {
        const int row0 = (u.pm - 64) * 256 + wr * 64 + fr, col0 = (u.pn - 4) * 256 + wc * 32 + 8 * fq;
#pragma unroll
        for (int ai = 0; ai < 2; ++ai) { v4u gb[4][2];
#pragma unroll
            for (int m = 0; m < 4; ++m)
#pragma unroll
                for (int bj = 0; bj < 2; ++bj) gb[m][bj] = *(const v4u*)(proj + (size_t)(row0 + ai * 128 + m * 16) * NPROJ + PC_GB + col0 + bj * 128);
#pragma unroll
            for (int m = 0; m < 4; ++m) { const size_t row = (size_t)(row0 + ai * 128 + m * 16);
#pragma unroll
                for (int bj = 0; bj < 2; ++bj) { const v4u g = gb[m][bj]; pg8::f32x4 v0 = acc[ai][bj][m][0], v1 = acc[ai][bj][m][1];
                    v0[0] *= fmaxf(bflo(g.x), 1e-30f); v0[1] *= fmaxf(bfhi(g.x), 1e-30f); v0[2] *= fmaxf(bflo(g.y), 1e-30f); v0[3] *= fmaxf(bfhi(g.y), 1e-30f);
                    v1[0] *= fmaxf(bflo(g.z), 1e-30f); v1[1] *= fmaxf(bfhi(g.z), 1e-30f); v1[2] *= fmaxf(bflo(g.w), 1e-30f); v1[3] *= fmaxf(bfhi(g.w), 1e-30f);
                    v4u o; o.x = pg8::cvt_pk_bf16(v0[0], v0[1]); o.y = pg8::cvt_pk_bf16(v0[2], v0[3]); o.z = pg8::cvt_pk_bf16(v1[0], v1[1]); o.w = pg8::cvt_pk_bf16(v1[2], v1[3]);
                    *(v4u*)(mrg + row * DM + col0 + bj * 128) = o; } } }
    }
};
struct EpiResid {
    static constexpr bool PERM = true, AFTER_DRAIN = false;
    const float* base; float* out;
    __device__ __forceinline__ void operator()(const pg8::f32x4 (&acc)[2][2][4][2], const pg8::Unit& u, int wr, int wc, int fr, int fq) const {
        const int row0 = u.pm * 256 + wr * 64 + fr, col0 = u.pn * 256 + wc * 32 + 8 * fq;
#pragma unroll
        for (int ai = 0; ai < 2; ++ai)
#pragma unroll
            for (int m = 0; m < 4; ++m)
#pragma unroll
                for (int bj = 0; bj < 2; ++bj) { const size_t p = (size_t)(row0 + ai * 128 + m * 16) * DM + col0 + bj * 128;
                    const pg8::f32x4 b0 = *(const pg8::f32x4*)(base + p), b1 = *(const pg8::f32x4*)(base + p + 4);
                    *(pg8::f32x4*)(out + p) = b0 + acc[ai][bj][m][0]; *(pg8::f32x4*)(out + p + 4) = b1 + acc[ai][bj][m][1]; }
    }
};
constexpr size_t WS_X8 = WS_X1;
constexpr size_t WS_XB = WS_H;
constexpr size_t WS_SS = 690 * MiB + 1024 * 1024;
constexpr size_t WS_TOKR = 690 * MiB + 800 * 1024;
constexpr size_t WS_SLOTR = 774 * MiB, WS_SLOTT = 775 * MiB;
template <bool BF16_BASE> struct EpiResidStat {
    static constexpr bool PERM = true, AFTER_DRAIN = false;
    const float* basef; bf16* xb; float* ss; unsigned char* x8; float accs;
    __device__ __forceinline__ void operator()(const pg8::f32x4 (&acc)[2][2][4][2], const pg8::Unit& u, int wr, int wc, int fr, int fq) const {
        const int row0 = u.pm * 256 + wr * 64 + fr, col0 = u.pn * 256 + wc * 32 + 8 * fq;
#pragma unroll
        for (int ai = 0; ai < 2; ++ai) {
            v4u bb[4][2]; pg8::f32x4 bf[4][2][2];
#pragma unroll
            for (int m = 0; m < 4; ++m)
#pragma unroll
                for (int bj = 0; bj < 2; ++bj) { const size_t p = (size_t)(row0 + ai * 128 + m * 16) * DM + col0 + bj * 128;
                    if (BF16_BASE) bb[m][bj] = *(const v4u*)(xb + p); else { bf[m][bj][0] = *(const pg8::f32x4*)(basef + p); bf[m][bj][1] = *(const pg8::f32x4*)(basef + p + 4); } }
#pragma unroll
            for (int m = 0; m < 4; ++m) { const int row = row0 + ai * 128 + m * 16; float s = 0.f;
#pragma unroll
                for (int bj = 0; bj < 2; ++bj) { const size_t p = (size_t)row * DM + col0 + bj * 128;
                    pg8::f32x4 v0, v1;
                    if (BF16_BASE) { const v4u b = bb[m][bj]; v0 = (pg8::f32x4){bflo(b.x), bfhi(b.x), bflo(b.y), bfhi(b.y)}; v1 = (pg8::f32x4){bflo(b.z), bfhi(b.z), bflo(b.w), bfhi(b.w)}; }
                    else { v0 = bf[m][bj][0]; v1 = bf[m][bj][1]; }
                    v0 = v0 + acc[ai][bj][m][0] * accs; v1 = v1 + acc[ai][bj][m][1] * accs;
                    s += (v0[0] * v0[0] + v0[1] * v0[1]) + (v0[2] * v0[2] + v0[3] * v0[3]) + (v1[0] * v1[0] + v1[1] * v1[1]) + (v1[2] * v1[2] + v1[3] * v1[3]);
                    v4u o; o.x = pg8::cvt_pk_bf16(v0[0], v0[1]); o.y = pg8::cvt_pk_bf16(v0[2], v0[3]); o.z = pg8::cvt_pk_bf16(v1[0], v1[1]); o.w = pg8::cvt_pk_bf16(v1[2], v1[3]);
                    *(v4u*)(xb + p) = o;
                    if (x8 != nullptr) { v2u o8; o8.x = pk4_fp8(v0[0], v0[1], v0[2], v0[3]); o8.y = pk4_fp8(v1[0], v1[1], v1[2], v1[3]); *(v2u*)(x8 + p) = o8; } }
                s += __shfl_xor(s, 16); s += __shfl_xor(s, 32);
                if (fq == 0) ss[(size_t)row * 16 + u.pn * 4 + wc] = s; } }
    }
};
__device__ __forceinline__ float row_rstd(const float* ss, size_t row) {
    const pg8::f32x4* p = (const pg8::f32x4*)(ss + row * 16); const pg8::f32x4 a = p[0], b = p[1], c = p[2], d = p[3];
    return rsqrtf((((a[0] + a[1]) + (a[2] + a[3])) + ((b[0] + b[1]) + (b[2] + b[3])) + ((c[0] + c[1]) + (c[2] + c[3])) + ((d[0] + d[1]) + (d[2] + d[3]))) * (1.f / DM) + EPS);
}
struct EpiRowScale {
    static constexpr bool PERM = true, AFTER_DRAIN = false;
    bf16* O; const float* ss;
    __device__ __forceinline__ void operator()(const pg8::f32x4 (&acc)[2][2][4][2], const pg8::Unit& u, int wr, int wc, int fr, int fq) const {
        const int row0 = u.pm * 256 + wr * 64 + fr, col0 = u.pn * 256 + wc * 32 + 8 * fq;
#pragma unroll
        for (int ai = 0; ai < 2; ++ai)
#pragma unroll
            for (int m = 0; m < 4; ++m) { const size_t row = (size_t)(row0 + ai * 128 + m * 16); const float r = row_rstd(ss, row) * (FP8_X ? 1.f / W8_SCALE : 1.f);
#pragma unroll
                for (int bj = 0; bj < 2; ++bj) { const pg8::f32x4 v0 = acc[ai][bj][m][0] * r, v1 = acc[ai][bj][m][1] * r;
                    v4u o; o.x = pg8::cvt_pk_bf16(v0[0], v0[1]); o.y = pg8::cvt_pk_bf16(v0[2], v0[3]); o.z = pg8::cvt_pk_bf16(v1[0], v1[1]); o.w = pg8::cvt_pk_bf16(v1[2], v1[3]);
                    *(v4u*)(O + row * DM + col0 + bj * 128) = o; } }
    }
};
struct EpiSwiglu {
    static constexpr bool PERM = true, AFTER_DRAIN = false;
    bf16* act; const float* b1; const float* rr;
    __device__ __forceinline__ void operator()(const pg8::f32x4 (&acc)[2][2][4][2], const pg8::Unit& u, int wr, int wc, int fr, int fq) const {
        const int e = u.pn >> 3, j = u.pn & 7; const int row0 = u.pm * 256 + wr * 64 + fr, c0 = 128 * j + wc * 32 + 8 * fq;
        const float* bg = b1 + (size_t)e * 2048 + c0; const float* bl = bg + 1024;
        pg8::f32x4 bg0 = *(const pg8::f32x4*)bg, bg1 = *(const pg8::f32x4*)(bg + 4), bl0 = *(const pg8::f32x4*)bl, bl1 = *(const pg8::f32x4*)(bl + 4);
        float rsv[2][4];
#pragma unroll
        for (int ai = 0; ai < 2; ++ai)
#pragma unroll
            for (int m = 0; m < 4; ++m) rsv[ai][m] = rr[(size_t)(row0 + ai * 128 + m * 16)];
        asm volatile("" : "+v"(bg0), "+v"(bg1), "+v"(bl0), "+v"(bl1));
#pragma unroll
        for (int ai = 0; ai < 2; ++ai)
#pragma unroll
            for (int m = 0; m < 4; ++m) { const size_t row = (size_t)(row0 + ai * 128 + m * 16); const float rs = rsv[ai][m] * (MOE_F8 ? 1.f / W8_SCALE : 1.f);
                const pg8::f32x4 g0 = acc[ai][0][m][0] * rs + bg0,     g1 = acc[ai][0][m][1] * rs + bg1, l0 = acc[ai][1][m][0] * rs + bl0, l1 = acc[ai][1][m][1] * rs + bl1;
                float r[8];
#pragma unroll
                for (int i = 0; i < 4; ++i) { const float ga = fminf(g0[i], 7.f), la = fminf(fmaxf(l0[i], -7.f), 7.f); r[i] = ga * sigmoidf_(1.702f * ga) * (la + 1.f);
                    const float gb = fminf(g1[i], 7.f), lb = fminf(fmaxf(l1[i], -7.f), 7.f); r[4 + i] = gb * sigmoidf_(1.702f * gb) * (lb + 1.f); }
                if (MOE_F8) { v2u o; o.x = pk4_fp8(r[0], r[1], r[2], r[3]); o.y = pk4_fp8(r[4], r[5], r[6], r[7]); *(v2u*)((unsigned char*)act + row * 1024 + c0) = o; }
                else { v4u o; o.x = pg8::cvt_pk_bf16(r[0], r[1]); o.y = pg8::cvt_pk_bf16(r[2], r[3]); o.z = pg8::cvt_pk_bf16(r[4], r[5]); o.w = pg8::cvt_pk_bf16(r[6], r[7]);
                    *(v4u*)(act + row * 1024 + c0) = o; } }
    }
};
struct EpiMoeOut {
    static constexpr bool PERM = true, AFTER_DRAIN = false;
    bf16* ys; const float* b2; const float* sw;
    __device__ __forceinline__ void operator()(const pg8::f32x4 (&acc)[2][2][4][2], const pg8::Unit& u, int wr, int wc, int fr, int fq) const {
        const int e = u.pn >> 2; const int row0 = u.pm * 256 + wr * 64 + fr, col0 = (u.pn & 3) * 256 + wc * 32 + 8 * fq;
        pg8::f32x4 bv[2][2];
#pragma unroll
        for (int bj = 0; bj < 2; ++bj) { bv[bj][0] = *(const pg8::f32x4*)(b2 + (size_t)e * 1024 + col0 + bj * 128); bv[bj][1] = *(const pg8::f32x4*)(b2 + (size_t)e * 1024 + col0 + bj * 128 + 4); }
        float swv[2][4];
#pragma unroll
        for (int ai = 0; ai < 2; ++ai)
#pragma unroll
            for (int m = 0; m < 4; ++m) swv[ai][m] = sw[(size_t)(row0 + ai * 128 + m * 16)];
#pragma unroll
        for (int ai = 0; ai < 2; ++ai)
#pragma unroll
            for (int m = 0; m < 4; ++m) { const size_t row = (size_t)(row0 + ai * 128 + m * 16); const float w = swv[ai][m];
#pragma unroll
                for (int bj = 0; bj < 2; ++bj) { const float ws = MOE_F8 ? 1.f / W8_SCALE : 1.f; const pg8::f32x4 v0 = (acc[ai][bj][m][0] * ws + bv[bj][0]) * w, v1 = (acc[ai][bj][m][1] * ws + bv[bj][1]) * w;
                    v4u o; o.x = pg8::cvt_pk_bf16(v0[0], v0[1]); o.y = pg8::cvt_pk_bf16(v0[2], v0[3]); o.z = pg8::cvt_pk_bf16(v1[0], v1[1]); o.w = pg8::cvt_pk_bf16(v1[2], v1[3]);
                    *(v4u*)(ys + row * 1024 + col0 + bj * 128) = o; } }
    }
};
struct MoeOrder {
    int G, c, NT, nunits; const LAS int* blk_e;
    __device__ __forceinline__ bool next(int i, pg8::Unit& u) const {
        const int chunk = (nunits + 7) >> 3, ul = i * (G >> 3) + (c >> 3); if (ul >= chunk) return false;
        const int s = (c & 7) * chunk + ul; if (s >= nunits) return false;
        const int rb = s / NT, nt = s - rb * NT; u.pm = rb; u.pn = __builtin_amdgcn_readfirstlane(blk_e[rb]) * NT + nt; return true; }
    __device__ __forceinline__ void a_ready(const pg8::Unit&) const {}
    __device__ __forceinline__ void done(const pg8::Unit&) const {}
};

__device__ __forceinline__ void phase_xattn_simple(const Args& a, unsigned char* ldsg, int tid, int G, int bid) {
    float* qt = (float*)ldsg;
    float* sc = qt + 16384;
    float* pt = sc + 8192;
    const bf16* QX = WSP(const bf16, WS_QX); const bf16* KVX = WSP(const bf16, WS_KVX); bf16* OX = WSP(bf16, WS_OX);
    const int j = tid & 255, hs = tid >> 8;
    for (int grp = bid; grp < SEQ / 16; grp += G) {
        __syncthreads();
        { const int row = tid >> 5, seg = tid & 31; const v4u* sp = (const v4u*)(QX + (size_t)(grp * 16 + row) * DM + seg * 32); float* dp = qt + row * 1024 + seg * 32;
#pragma unroll
          for (int i = 0; i < 4; ++i) { const v4u r = sp[i];
#pragma unroll
              for (int w = 0; w < 4; ++w) { dp[8 * i + 2 * w] = bflo(r[w]); dp[8 * i + 2 * w + 1] = bfhi(r[w]); } } }
        __syncthreads();
        for (int it = 0; it < 2; ++it) { const int hh = hs + 2 * it;
            float s[16];
#pragma unroll
            for (int tok = 0; tok < 16; ++tok) s[tok] = 0.f;
            const bf16* kp = KVX + (size_t)j * 2048 + hh * 256;
#pragma unroll 2
            for (int p = 0; p < 32; ++p) { const v4u kr = *(const v4u*)(kp + 8 * p);
                const float k0 = bflo(kr.x), k1 = bfhi(kr.x), k2 = bflo(kr.y), k3 = bfhi(kr.y), k4 = bflo(kr.z), k5 = bfhi(kr.z), k6 = bflo(kr.w), k7 = bfhi(kr.w);
#pragma unroll
                for (int tok = 0; tok < 16; ++tok) { const f32x4* q4 = (const f32x4*)(qt + tok * 1024 + hh * 256 + 8 * p); const f32x4 qa = q4[0], qb = q4[1];
                    s[tok] += (qa.x * k0 + qa.y * k1) + (qa.z * k2 + qa.w * k3) + (qb.x * k4 + qb.y * k5) + (qb.z * k6 + qb.w * k7); } }
#pragma unroll
            for (int tok = 0; tok < 16; ++tok) sc[(hs * 16 + tok) * 256 + j] = s[tok] * 0.0625f;
            __syncthreads();
            { const int tok = (tid & 255) >> 4, part = tid & 15; const float* sr = sc + (hs * 16 + tok) * 256 + part * 16;
              float v[16]; float mx = -INFINITY;
#pragma unroll
              for (int i = 0; i < 16; ++i) { v[i] = sr[i]; mx = fmaxf(mx, v[i]); }
              mx = fmaxf(mx, __shfl_xor(mx, 1)); mx = fmaxf(mx, __shfl_xor(mx, 2)); mx = fmaxf(mx, __shfl_xor(mx, 4)); mx = fmaxf(mx, __shfl_xor(mx, 8));
              float sm = 0.f;
#pragma unroll
              for (int i = 0; i < 16; ++i) { v[i] = __expf(v[i] - mx); sm += v[i]; }
              sm += __shfl_xor(sm, 1); sm += __shfl_xor(sm, 2); sm += __shfl_xor(sm, 4); sm += __shfl_xor(sm, 8);
              const float inv = 1.f / sm;
#pragma unroll
              for (int i = 0; i < 16; ++i) pt[(hs * 256 + part * 16 + i) * 16 + tok] = v[i] * inv; }
            __syncthreads();
            { float o[16];
#pragma unroll
              for (int tok = 0; tok < 16; ++tok) o[tok] = 0.f;
              const bf16* vp = KVX + 1024 + hh * 256 + j;
#pragma unroll 4
              for (int jj = 0; jj < 256; ++jj) { const float v = bf2f(vp[(size_t)jj * 2048]); const f32x4* p4 = (const f32x4*)(pt + (hs * 256 + jj) * 16);
#pragma unroll
                  for (int c = 0; c < 4; ++c) { const f32x4 pp = p4[c]; o[4 * c] += pp.x * v; o[4 * c + 1] += pp.y * v; o[4 * c + 2] += pp.z * v; o[4 * c + 3] += pp.w * v; } }
#pragma unroll
              for (int tok = 0; tok < 16; ++tok) OX[(size_t)(grp * 16 + tok) * DM + hh * 256 + j] = (bf16)f2bf(o[tok]); }
        }
    }
}

__device__ __forceinline__ void phase_router(const Args& a, unsigned char* ldsg, int lane, int wave, int gw, int NGW) {
    const bf16* X2 = WSP(const bf16, WS_XB); const float* Wr = a.in[23]; const float* br = a.in[24];
    int* TOPE = WSP(int, WS_TOPE); float* TOPW = WSP(float, WS_TOPW); unsigned* cnt = WSP(unsigned, WS_CTL) + CW_CNT;
    float* hT = (float*)ldsg + wave * 4096;
    const int e = lane & 31, kh = lane >> 5;
    { int* SLOTT = WSP(int, WS_SLOTT); for (int i = gw * 64 + lane; i < 73728; i += NGW * 64) SLOTT[i] = 0; }
    const float bre = br[e];
    for (int t0 = gw * 4; t0 < SEQ; t0 += NGW * 4) {
#pragma unroll
        for (int r = 0; r < 4; ++r) { f32x4 v[4]; const float rstd = rms_row_load_bf16(X2 + (size_t)(t0 + r) * DM, a.in[22], lane, v); if (lane == 0) WSP(float, WS_TOKR)[t0 + r] = rstd;
#pragma unroll
            for (int j = 0; j < 4; ++j)
#pragma unroll
                for (int c = 0; c < 4; ++c) hT[(4 * lane + 256 * j + c) * 4 + r] = v[j][c]; }
        LDS_WAIT(); asm volatile("" ::: "memory");
        float p[4] = {0.f, 0.f, 0.f, 0.f};
        const float* wp = Wr + (size_t)(kh * 512) * 32 + e; const f32x4* hp = (const f32x4*)hT + kh * 512;
#pragma unroll 8
        for (int k = 0; k < 512; ++k) { const float w = wp[(size_t)k * 32]; const f32x4 h4 = hp[k]; p[0] += h4.x * w; p[1] += h4.y * w; p[2] += h4.z * w; p[3] += h4.w * w; }
#pragma unroll
        for (int r = 0; r < 4; ++r) { const int t = t0 + r;
            float pr = p[r] + __shfl_xor(p[r], 32);
            float mine = (lane < 32) ? pr + bre : -INFINITY;
            float tv[4]; int te[4];
#pragma unroll
            for (int q = 0; q < 4; ++q) { float bv = mine; int bi = lane;
#pragma unroll
                for (int o = 1; o < 64; o <<= 1) { const float ov = __shfl_xor(bv, o); const int oi = __shfl_xor(bi, o); if (ov > bv || (ov == bv && oi < bi)) { bv = ov; bi = oi; } }
                tv[q] = bv; te[q] = bi; if (lane == bi) mine = -INFINITY; }
            const float e1 = expf(tv[1] - tv[0]), e2 = expf(tv[2] - tv[0]), e3 = expf(tv[3] - tv[0]); const float inv = 1.f / (1.f + e1 + e2 + e3);
            if (lane < 4) { const int ee = lane == 0 ? te[0] : lane == 1 ? te[1] : lane == 2 ? te[2] : te[3]; const float ww = (lane == 0 ? 1.f : lane == 1 ? e1 : lane == 2 ? e2 : e3) * inv;
                TOPE[t * 4 + lane] = ee; TOPW[t * 4 + lane] = ww; atomicAdd(&cnt[(t >> 6) * 32 + ee], 1u); } }
        asm volatile("" ::: "memory");
    }
}

__device__ __forceinline__ void phase_router_mfma(const Args& a, LAS unsigned char* L, int tid, int lane, int wave, int G, int bid, int gw, int NGW) {
    const bf16* X2 = WSP(const bf16, WS_XB); const float* br = a.in[24]; const bf16* WRH = WSP(const bf16, WS_WRH); const bf16* WRL = WSP(const bf16, WS_WRL);
    int* TOPE = WSP(int, WS_TOPE); float* TOPW = WSP(float, WS_TOPW); unsigned* cnt = WSP(unsigned, WS_CTL) + CW_CNT; const float* SS = WSP(const float, WS_SS);
    { int* SLOTT = WSP(int, WS_SLOTT); for (int i = gw * 64 + lane; i < 73728; i += NGW * 64) SLOTT[i] = 0; }
    LAS float* LG = (LAS float*)L;
    const int l15 = lane & 15, quad = lane >> 4;
    const float bre = br[lane & 31];
    for (int rb = bid; rb < SEQ / 64; rb += G) { const int t0 = rb * 64;
        __syncthreads();
        { const int rt = wave & 3, nt_ = wave >> 2;
            pg8::f32x4 acc0 = {0.f, 0.f, 0.f, 0.f};
            const bf16* xr = X2 + (size_t)(t0 + 16 * rt + l15) * DM + 8 * quad;
            const bf16* wh0 = WRH + (size_t)(16 * nt_ + l15) * 1024 + 8 * quad; const bf16* wl0 = WRL + (size_t)(16 * nt_ + l15) * 1024 + 8 * quad;
#pragma unroll 1
            for (int kg = 0; kg < 4; ++kg) {
                pg8::bf16x8 af[8], bh0[8], bl0[8];
#pragma unroll
                for (int q = 0; q < 8; ++q) { const int ko = 256 * kg + 32 * q; af[q] = *(const pg8::bf16x8*)(xr + ko); bh0[q] = *(const pg8::bf16x8*)(wh0 + ko); bl0[q] = *(const pg8::bf16x8*)(wl0 + ko); }
#pragma unroll
                for (int q = 0; q < 8; ++q) { acc0 = __builtin_amdgcn_mfma_f32_16x16x32_bf16(af[q], bh0[q], acc0, 0, 0, 0); acc0 = __builtin_amdgcn_mfma_f32_16x16x32_bf16(af[q], bl0[q], acc0, 0, 0, 0); } }
#pragma unroll
            for (int r = 0; r < 4; ++r) LG[(16 * rt + 4 * quad + r) * 32 + 16 * nt_ + l15] = acc0[r];
        }
        __syncthreads();
        { const int e = lane & 31;
#pragma unroll
          for (int pp = 0; pp < 4; ++pp) { const int rl = 8 * wave + 2 * pp + (lane >> 5), t = t0 + rl;
            const float rstd = row_rstd(SS, (size_t)t); if (e == 0) WSP(float, WS_TOKR)[t] = rstd;
            float mine = LG[rl * 32 + e] * rstd + bre;
            float tv[4]; int te[4];
#pragma unroll
            for (int q = 0; q < 4; ++q) { float bv = mine; int bi = e;
#pragma unroll
                for (int o = 1; o < 32; o <<= 1) { const float ov = __shfl_xor(bv, o); const int oi = __shfl_xor(bi, o); if (ov > bv || (ov == bv && oi < bi)) { bv = ov; bi = oi; } }
                tv[q] = bv; te[q] = bi; if (e == bi) mine = -INFINITY; }
            const float e1 = expf(tv[1] - tv[0]), e2 = expf(tv[2] - tv[0]), e3 = expf(tv[3] - tv[0]); const float inv = 1.f / (1.f + e1 + e2 + e3);
            if (e < 4) { const int ee = e == 0 ? te[0] : e == 1 ? te[1] : e == 2 ? te[2] : te[3]; const float ww = (e == 0 ? 1.f : e == 1 ? e1 : e == 2 ? e2 : e3) * inv;
                TOPE[t * 4 + e] = ee; TOPW[t * 4 + e] = ww; atomicAdd(&cnt[(t >> 6) * 32 + ee], 1u); } } }
    }
}

__device__ __forceinline__ void moe_tables(const Args& a, unsigned char* ldsg, int tid, int myblk) {
    const unsigned* cnt = WSP(const unsigned, WS_CTL) + CW_CNT;
    int* part_tot = (int*)ldsg; int* part_bef = part_tot + 512; int* X = (int*)(ldsg + EXTRA_OFF);
    __syncthreads();
    { const int e = tid & 31, part = tid >> 5; int st = 0, sb = 0;
      for (int b = part * 16; b < part * 16 + 16; ++b) { const int c = (int)__hip_atomic_load(&cnt[b * 32 + e], RLX_AGENT); st += c; sb += (b < myblk) ? c : 0; }
      part_tot[part * 32 + e] = st; part_bef[part * 32 + e] = sb; }
    __syncthreads();
    if (tid < 32) { int t = 0, b = 0; for (int p = 0; p < 16; ++p) { t += part_tot[p * 32 + tid]; b += part_bef[p * 32 + tid]; } X[tid] = t; X[32 + tid] = b; }
    __syncthreads();
    if (tid < 64) { const int e = tid & 31; const int k = (X[e] + 255) >> 8;
        int incl = k;
#pragma unroll
        for (int o = 1; o < 32; o <<= 1) { const int v = __shfl_up(incl, o); if (e >= o) incl += v; }
        const int nb0 = incl - k;
        if (tid < 32) { X[64 + e] = nb0 * 256; for (int i = 0; i < k; ++i) X[128 + nb0 + i] = e; if (e == 31) X[96] = incl; } }
    __syncthreads();
}
__device__ __forceinline__ void phase_slots(const Args& a, unsigned char* ldsg, int tid, int lane, int wave, int G, int bid) {
    const int* TOPE = WSP(const int, WS_TOPE); const float* TOPW = WSP(const float, WS_TOPW); int* SPOS = WSP(int, WS_SPOS); float* SLOTW = WSP(float, WS_SLOTW);
    const bf16* H = WSP(const bf16, WS_XB); bf16* XS = WSP(bf16, WS_XS); const float* TOKR = WSP(const float, WS_TOKR); float* SLOTR = WSP(float, WS_SLOTR);
    int* X = (int*)(ldsg + EXTRA_OFF); int* posl = (int*)(ldsg + 8192);
    for (int blk = bid; blk < SEQ / 64; blk += G) {
        moe_tables(a, ldsg, tid, blk);
        if (wave == 0) { const int t = blk * 64 + lane;
            int ek[4], before[4] = {0, 0, 0, 0}, sofar[4] = {0, 0, 0, 0};
#pragma unroll
            for (int k = 0; k < 4; ++k) ek[k] = TOPE[t * 4 + k];
#pragma unroll
            for (int k = 0; k < 4; ++k)
                for (int ee = 0; ee < 32; ++ee) { const unsigned long long mk = __ballot(ek[k] == ee); const int c = __popcll(mk);
                    if (ek[k] == ee) before[k] = __popcll(mk & ((1ull << lane) - 1ull));
#pragma unroll
                    for (int k2 = k + 1; k2 < 4; ++k2) if (ek[k2] == ee) sofar[k2] += c; }
#pragma unroll
            for (int k = 0; k < 4; ++k) { const int pos = X[64 + ek[k]] + X[32 + ek[k]] + sofar[k] + before[k];
                SPOS[t * 4 + k] = pos; SLOTW[pos] = TOPW[t * 4 + k]; SLOTR[pos] = TOKR[t]; WSP(int, WS_SLOTT)[pos] = t; } }
    }
}

__device__ __forceinline__ void phase_final(const Args& a, int lane, int gw, int NGW) {
    const bf16* X2 = WSP(const bf16, WS_XB); const int* SPOS = WSP(const int, WS_SPOS); const bf16* YS = WSP(const bf16, WS_YS); const float* g = a.in[29];
    for (int t = gw; t < SEQ; t += NGW) {
        const v2u* xr = (const v2u*)(X2 + (size_t)t * DM) + lane; f32x4 v[4];
#pragma unroll
        for (int j = 0; j < 4; ++j) { const v2u r = xr[64 * j]; v[j] = (f32x4){bflo(r.x), bfhi(r.x), bflo(r.y), bfhi(r.y)}; }
#pragma unroll
        for (int k = 0; k < 4; ++k) { const int pos = SPOS[t * 4 + k]; const v2u* yr = (const v2u*)(YS + (size_t)pos * DM) + lane;
#pragma unroll
            for (int j = 0; j < 4; ++j) { const v2u r = yr[64 * j]; v[j].x += bflo(r.x); v[j].y += bfhi(r.x); v[j].z += bflo(r.y); v[j].w += bfhi(r.y); } }
        float s = 0.f;
#pragma unroll
        for (int j = 0; j < 4; ++j) s += (v[j].x * v[j].x + v[j].y * v[j].y) + (v[j].z * v[j].z + v[j].w * v[j].w);
        const float rstd = rsqrtf(wave_sum(s) * (1.f / DM) + EPS);
        f32x4* orow = (f32x4*)(a.out + (size_t)t * DM) + lane;
#pragma unroll
        for (int j = 0; j < 4; ++j) { const f32x4 gv = ((const f32x4*)g)[lane + 64 * j]; orow[64 * j] = v[j] * rstd * gv; }
    }
}


namespace att {
using bf16x8 = __attribute__((ext_vector_type(8))) short;
using s16x4 = __attribute__((ext_vector_type(4))) short;
using f32x16 = __attribute__((ext_vector_type(16))) float;
typedef short v4i16_t __attribute__((ext_vector_type(4)));
using u32x4_t = __attribute__((ext_vector_type(4))) unsigned;
typedef float f32x2_t __attribute__((ext_vector_type(2))); typedef __bf16 bf16x2_t __attribute__((ext_vector_type(2)));
constexpr int SLOT = 32768, OFF_K = 0, OFF_V = 16384;
constexpr int LDS_WS = 98304;
constexpr int LDS_WS2 = EXTRA_OFF + 5376;
constexpr int TAB_OFF = EXTRA_OFF;
constexpr float LOG2E = 1.4426950408889634f, C2 = 0.125f * 1.4426950408889634f;
__device__ __forceinline__ int crow(int r, int hi) { return (r & 3) + 8 * (r >> 2) + 4 * hi; }
__device__ __forceinline__ void glds16(const void* gsrc, unsigned lds_dst) { unsigned keep;
    asm volatile("s_mov_b32 %0, m0\n\ts_mov_b32 m0, %2\n\ts_nop 0\n\tglobal_load_lds_dwordx4 %1, off\n\ts_mov_b32 m0, %0" : "=&s"(keep) : "v"(gsrc), "s"(lds_dst) : "memory"); }
__device__ __forceinline__ unsigned cvtpk_s(float lo, float hi) { f32x2_t v = {lo, hi}; bf16x2_t b = __builtin_convertvector(v, bf16x2_t); return __builtin_bit_cast(unsigned, b); }
__device__ __forceinline__ s16x4 vtr(const LAS char* p) { return __builtin_bit_cast(s16x4, __builtin_amdgcn_ds_read_tr16_b64_v4i16((LAS v4i16_t*)p)); }
__device__ __forceinline__ float max3f(float a, float b, float c) { float r; asm("v_max3_f32 %0, %1, %2, %3" : "=v"(r) : "v"(a), "v"(b), "v"(c)); return r; }
#define ATT_WAIT_BAR_(N) asm volatile("s_waitcnt vmcnt(" #N ") lgkmcnt(0)\n\ts_barrier" ::: "memory")
#define ATT_WAIT_BAR(N) ATT_WAIT_BAR_(N)
#if PV_F8
#define ATT_NV 3
#else
#define ATT_NV 4
#endif
typedef int v2i32_t __attribute__((ext_vector_type(2)));
__device__ __forceinline__ int pk4_fp8a(float a, float b, float c, float d) { int w; asm("v_cvt_pk_fp8_f32 %0, %1, %2" : "=v"(w) : "v"(a), "v"(b)); asm("v_cvt_pk_fp8_f32 %0, %1, %2 op_sel:[0,0,1]" : "+v"(w) : "v"(c), "v"(d)); return w; }
__device__ __forceinline__ v2i32_t vtr8(const LAS char* p) { return __builtin_amdgcn_ds_read_tr8_b64_v2i32((LAS v2i32_t*)p); }
#define ATT_BAR_PLAIN() asm volatile("s_waitcnt lgkmcnt(0)\n\ts_barrier" ::: "memory")

__device__ __forceinline__ void build_tables(const Args& a, LAS unsigned char* L, int tid) {
    LAS float* TAB = (LAS float*)(L + TAB_OFF);
    for (int i = tid; i < 4 * 320; i += NTHR) { const int h = i / 320, j = i - h * 320; TAB[i] = j < 319 ? (a.in[4][t5_bucket(j - 255) * 4 + h] - a.in[4][15 * 4 + h]) * LOG2E : 0.f; }
    if (tid < 4) TAB[1280 + tid] = a.in[4][15 * 4 + tid] * LOG2E;
    __syncthreads();
}

#ifndef ATT_COMPL
#define ATT_COMPL 1
#endif
#ifndef ATT_AHALF
#define ATT_AHALF 0
#endif
#ifndef ATT_PRIO
#define ATT_PRIO 0
#endif
#ifndef ATT_LAGSH
#define ATT_LAGSH 0
#endif
template <int THRL, int ABL = 0, bool STAG = false>
__device__ __forceinline__ void attn_unit(const Args& a, LAS unsigned char* L, int h, int qt, float lam) {
    const int tid = threadIdx.x, lane = tid & 63, r32 = lane & 31, hi = lane >> 5;
    const int wid = __builtin_amdgcn_readfirstlane(tid >> 6), rg = wid & 3, map = wid >> 2;
    const bf16* PROJ = WSP(const bf16, WS_PROJ);
    const int q0w = qt * 128 + rg * 32, mychunk = 2 * qt + (rg >> 1), nkt = 2 * qt + 2;
    const unsigned lds0 = (unsigned)(uintptr_t)L;
    LAS float* wsf = (LAS float*)(L + (STAG ? LDS_WS2 : LDS_WS)) + wid * 64;
    const LAS float* TAB = (const LAS float*)(L + TAB_OFF);
    const float farb2 = TAB[1280 + h];
    const int krow = 8 * wid + (lane >> 3);
    const bf16* ksrc0 = PROJ + (size_t)krow * NPROJ + PC_KA + h * 128 + (((lane & 7) ^ ((krow >> 1) & 7)) * 8);
    const bf16* vsrc0 = PROJ + (size_t)(16 * (wid & 3) + (lane >> 2)) * NPROJ + PC_VA + h * 128 + (wid >> 2) * 32 + (lane & 3) * 8;
    const unsigned kdst = lds0 + OFF_K + wid * 1024, vdst = lds0 + OFF_V + wid * 1024;
#if PV_F8
    const unsigned char* vsrc8 = (const unsigned char*)a.ws + WS_VIMG + (size_t)h * 256 * 8192 + wid * 1024 + lane * 16;
#define ATT_DMA(t, so) do { const size_t ro_ = (size_t)(t) * 64 * NPROJ; \
        glds16(ksrc0 + ro_, (unsigned)__builtin_amdgcn_readfirstlane(kdst + (so))); glds16(ksrc0 + ro_ + 64, (unsigned)__builtin_amdgcn_readfirstlane(kdst + (so) + 8192)); \
        glds16(vsrc8 + (size_t)(t) * 8192, (unsigned)__builtin_amdgcn_readfirstlane(vdst + (so))); } while (0)
#else
#define ATT_DMA(t, so) do { const size_t ro_ = (size_t)(t) * 64 * NPROJ; \
        glds16(ksrc0 + ro_, (unsigned)__builtin_amdgcn_readfirstlane(kdst + (so))); glds16(ksrc0 + ro_ + 64, (unsigned)__builtin_amdgcn_readfirstlane(kdst + (so) + 8192)); \
        glds16(vsrc0 + ro_, (unsigned)__builtin_amdgcn_readfirstlane(vdst + (so))); glds16(vsrc0 + ro_ + 64, (unsigned)__builtin_amdgcn_readfirstlane(vdst + (so) + 8192)); } while (0)
#endif
    constexpr float PO = PV_F8 ? 8.f : 0.f, THRF = PV_F8 ? 0.5f : (float)THRL;
    asm volatile("s_waitcnt vmcnt(0)" ::: "memory");
    if (ABL != 4 && ABL != 9 && ABL != 10 && ABL != 11) { ATT_DMA(0, 0); ATT_DMA(1, SLOT); }
    const int lagw = (wid >> ATT_LAGSH) & 1;
    if (STAG && lagw == 1) { ATT_WAIT_BAR(4); }
    bf16x8 qr[4];
    { const bf16* Qw = PROJ + (size_t)(q0w + r32) * NPROJ + PC_QA + h * 128 + map * 64 + hi * 8;
#pragma unroll
      for (int d0 = 0; d0 < 4; ++d0) qr[d0] = *reinterpret_cast<const bf16x8*>(Qw + d0 * 16); }
    asm volatile("" : "+v"(qr[0]), "+v"(qr[1]), "+v"(qr[2]), "+v"(qr[3]));
    float mhat = 0.f, l = 0.f;
    f32x16 o[4];
#pragma unroll
    for (int d0 = 0; d0 < 4; ++d0) o[d0] = f32x16{};
    f32x16 cinF;
#pragma unroll
    for (int r = 0; r < 16; ++r) cinF[r] = farb2;
    int so_cur = 0, so_nn = 2 * SLOT;
    const LAS char* vbase8 = (const LAS char*)L + OFF_V + (lane >> 5) * 256 + ((lane & 15) >> 1) * 32 + ((lane >> 4) & 1) * 16 + (lane & 1) * 8;
    pg8::i32x8_ pa8, vb8[4];
    const LAS char* kbase = (const LAS char*)L + OFF_K + map * 8192 + r32 * 128;
    int koff[4];
#pragma unroll
    for (int j = 0; j < 4; ++j) koff[j] = (((2 * j + hi) ^ ((r32 >> 1) & 7)) * 16);
    const LAS char* vbase = (const LAS char*)L + OFF_V + ((lane >> 4) & 1) * 32 + (lane & 3) * 8 + (4 * hi + ((lane & 15) >> 2)) * 64;
    u32x4_t pw[4];
    for (int kt = 0; kt < nkt; ++kt) {
        if (ABL != 7 && ABL != 9 && ABL != 10 && ABL != 11) { if (kt + 1 < nkt) { ATT_WAIT_BAR(ATT_NV); } else { ATT_WAIT_BAR(0); } }
        if (ABL != 4 && ABL != 7 && ABL != 9 && ABL != 10 && ABL != 11) { if (kt + 2 < nkt) ATT_DMA(kt + 2, so_nn); }
        if (kt <= mychunk) {
            const LAS char* kp = kbase + so_cur;
            bf16x8 kf[8];
#pragma unroll
            for (int j = 0; j < ((ABL == 6 || ABL == 8 || ABL == 9 || ABL == 11) ? 0 : 4); ++j) { kf[2 * j] = *(const LAS bf16x8*)(kp + koff[j]); kf[2 * j + 1] = *(const LAS bf16x8*)(kp + koff[j] + 4096); }
            if (ABL == 0) asm volatile("" : "+v"(kf[0]), "+v"(kf[1]), "+v"(kf[2]), "+v"(kf[3]), "+v"(kf[4]), "+v"(kf[5]), "+v"(kf[6]), "+v"(kf[7]));
            const bool far = (kt * 64 + 63 - q0w) <= -128;
            const f32x16 cin = cinF;
            f32x16 p0 = cin, p1 = cin;
            if (ABL != 6 && ABL != 11 && (ABL < 8 || ABL == 10)) { p0 = __builtin_amdgcn_mfma_f32_32x32x16_bf16(kf[0], qr[0], cin, 0, 0, 0);
            p1 = __builtin_amdgcn_mfma_f32_32x32x16_bf16(kf[1], qr[0], cin, 0, 0, 0); }
#pragma unroll
            for (int d0 = 1; d0 < ((ABL == 6 || ABL == 8 || ABL == 9 || ABL == 11) ? 1 : 4); ++d0) { p0 = __builtin_amdgcn_mfma_f32_32x32x16_bf16(kf[2 * d0], qr[d0], p0, 0, 0, 0); p1 = __builtin_amdgcn_mfma_f32_32x32x16_bf16(kf[2 * d0 + 1], qr[d0], p1, 0, 0, 0); }
            if (PV_F8 && !(ABL == 2 || ABL == 8 || ABL == 9 || ABL == 11)) { const LAS char* vp = vbase8 + so_cur;
#pragma unroll
                for (int db = 0; db < 4; ++db)
#pragma unroll
                    for (int j = 0; j < 4; ++j) { const v2i32_t t = vtr8(vp + db * 2048 + j * 512); vb8[db][2 * j] = t[0]; vb8[db][2 * j + 1] = t[1]; } }
            if (!far) { const LAS float* tb = TAB + h * 320 + 255 + kt * 64 - (q0w + r32) + 4 * hi;
#pragma unroll
                for (int r = 0; r < 16; ++r) { p0[r] += tb[(r & 3) + 8 * (r >> 2)]; p1[r] += tb[32 + (r & 3) + 8 * (r >> 2)]; } }
            float sacc = 0.f; bool resc = false;
            if (ABL != 5 && ABL != 10 && (ABL < 8 || ABL == 11)) {
            float rma = max3f(p0[0], p0[1], p1[0]), rmb = max3f(p0[2], p0[3], p1[1]); rma = max3f(rma, p1[2], p1[3]);
#pragma unroll
            for (int r = 4; r < 16; r += 4) { rma = max3f(rma, p0[r], p0[r + 1]); rmb = max3f(rmb, p0[r + 2], p0[r + 3]); rma = max3f(rma, p1[r], p1[r + 1]); rmb = max3f(rmb, p1[r + 2], p1[r + 3]); }
            float rm = max3f(rma, rmb, rmb);
            { auto rr = __builtin_amdgcn_permlane32_swap(__float_as_uint(rm), __float_as_uint(rm), false, false); rm = max3f(__uint_as_float(rr[0]), __uint_as_float(rr[1]), __uint_as_float(rr[1])); }
            if (kt == 0 || __any(rm > THRF + PO)) {
                const float dl = (kt == 0) ? rm - PO : fmaxf(rm - PO, 0.f); mhat += dl;
#pragma unroll
                for (int r = 0; r < 16; ++r) { p0[r] -= dl; p1[r] -= dl; }
                const float f = __builtin_amdgcn_exp2f(-dl); l *= f; if (hi == 0) wsf[r32] = f; resc = (kt != 0);
#pragma unroll
                for (int r = 0; r < 16; ++r) cinF[r] = farb2 - mhat; }
#pragma unroll
            for (int r = 0; r < 16; ++r) { if (ABL != 1) { p0[r] = __builtin_amdgcn_exp2f(p0[r]); p1[r] = __builtin_amdgcn_exp2f(p1[r]); } sacc += p0[r] + p1[r]; }
            }
            l += sacc;
            if (resc) { asm volatile("s_waitcnt lgkmcnt(0)" ::: "memory");
#pragma unroll
                for (int r = 0; r < 16; ++r) { const float f = wsf[crow(r, hi)];
#pragma unroll
                    for (int d0 = 0; d0 < 4; ++d0) o[d0][r] *= f; } }
            if (PV_F8) {
#pragma unroll
                for (int g = 0; g < 4; ++g) { pa8[g] = pk4_fp8a(p0[4 * g], p0[4 * g + 1], p0[4 * g + 2], p0[4 * g + 3]); pa8[4 + g] = pk4_fp8a(p1[4 * g], p1[4 * g + 1], p1[4 * g + 2], p1[4 * g + 3]); }
            } else {
#pragma unroll
            for (int w = 0; w < 4; ++w) { pw[0][w] = cvtpk_s(p0[2 * w], p0[2 * w + 1]); pw[1][w] = cvtpk_s(p0[8 + 2 * w], p0[8 + 2 * w + 1]); pw[2][w] = cvtpk_s(p1[2 * w], p1[2 * w + 1]); pw[3][w] = cvtpk_s(p1[8 + 2 * w], p1[8 + 2 * w + 1]); } }
        }
        if (STAG) { if (kt + 2 < nkt) { ATT_WAIT_BAR(4); } else { ATT_WAIT_BAR(0); } }
        if (PV_F8 && kt <= mychunk && !(ABL == 2 || ABL == 8 || ABL == 9 || ABL == 11)) {
            asm volatile("s_nop 3" ::: );
#pragma unroll
            for (int db = 0; db < 4; ++db)
                asm volatile("v_mfma_scale_f32_32x32x64_f8f6f4 %0, %1, %2, %0, %3, %3 op_sel_hi:[0,0,0]" : "+v"(o[db]) : "v"(pa8), "v"(vb8[db]), "v"(0x7f7f7f7f));
        }
        if (!PV_F8 && kt <= mychunk) {
            const LAS char* vp = vbase + so_cur;
            constexpr int ND = (ABL == 2 || ABL == 8 || ABL == 9 || ABL == 11) ? 0 : 4;
            s16x4 vlo[2][4], vhi[2][4];
            if (ND) {
#pragma unroll
                for (int ks = 0; ks < 4; ++ks) { vlo[0][ks] = vtr(vp + ks * 1024); vhi[0][ks] = vtr(vp + ks * 1024 + 512); } }
#pragma unroll
            for (int d0 = 0; d0 < ND; ++d0) {
                if (d0 + 1 < ND) {
#pragma unroll
                    for (int ks = 0; ks < 4; ++ks) { vlo[(d0 + 1) & 1][ks] = vtr(vp + (d0 + 1) * 4096 + ks * 1024); vhi[(d0 + 1) & 1][ks] = vtr(vp + (d0 + 1) * 4096 + ks * 1024 + 512); } }
#pragma unroll
                for (int ks = 0; ks < 4; ++ks) { const s16x4 x = vlo[d0 & 1][ks], y = vhi[d0 & 1][ks]; const bf16x8 vf = (bf16x8){x[0], x[1], x[2], x[3], y[0], y[1], y[2], y[3]};
                    o[d0] = __builtin_amdgcn_mfma_f32_32x32x16_bf16(__builtin_bit_cast(bf16x8, pw[ks]), vf, o[d0], 0, 0, 0); }
            }
            if (ABL == 0) {
                __builtin_amdgcn_sched_group_barrier(0x100, 8, 0);
#pragma unroll
                for (int i = 0; i < 12; ++i) { __builtin_amdgcn_sched_group_barrier(0x8, 1, 0); __builtin_amdgcn_sched_group_barrier(0x100, 2, 0); }
                __builtin_amdgcn_sched_group_barrier(0x8, 4, 0); }
        }
        if (STAG) { so_cur = (so_cur + SLOT) & (4 * SLOT - 1); so_nn = (so_nn + SLOT) & (4 * SLOT - 1); }
        else { so_cur = (so_cur == 2 * SLOT) ? 0 : so_cur + SLOT; so_nn = (so_nn == 2 * SLOT) ? 0 : so_nn + SLOT; }
    }
    if (STAG && lagw == 0) { ATT_BAR_PLAIN(); }
    if (PV_F8) asm volatile("s_nop 15\n\ts_nop 15" ::: );
    { auto rr = __builtin_amdgcn_permlane32_swap(__float_as_uint(l), __float_as_uint(l), false, false); l = __uint_as_float(rr[0]) + __uint_as_float(rr[1]); }
    if (hi == 0) wsf[32 + r32] = l;
    asm volatile("s_waitcnt lgkmcnt(0)" ::: "memory");
    float rli[16];
#pragma unroll
    for (int r = 0; r < 16; ++r) rli[r] = 1.f / wsf[32 + crow(r, hi)];
#pragma unroll
    for (int d0 = 0; d0 < 4; ++d0)
#pragma unroll
        for (int r = 0; r < 16; ++r) o[d0][r] *= rli[r];
    ATT_WAIT_BAR(0);
    LAS float* EX = (LAS float*)L + rg * 4096;
    if (map == 1) {
#pragma unroll
        for (int d0 = 0; d0 < 4; ++d0)
#pragma unroll
            for (int r = 0; r < 16; ++r) EX[(d0 * 16 + r) * 64 + lane] = o[d0][r]; }
    ATT_WAIT_BAR(0);
    if (map == 0) {
        float ss[16];
#pragma unroll
        for (int r = 0; r < 16; ++r) ss[r] = 0.f;
#pragma unroll
        for (int d0 = 0; d0 < 4; ++d0)
#pragma unroll
            for (int r = 0; r < 16; ++r) { const float x = o[d0][r] - lam * EX[(d0 * 16 + r) * 64 + lane]; o[d0][r] = x; ss[r] += x * x; }
#pragma unroll
        for (int r = 0; r < 16; ++r) { float s = ss[r]; s += __shfl_xor(s, 1); s += __shfl_xor(s, 2); s += __shfl_xor(s, 4); s += __shfl_xor(s, 8); s += __shfl_xor(s, 16); ss[r] = rsqrtf(s * (1.f / 128.f) + EPS) * 0.8f; }
        bf16* OA = WSP(bf16, WS_OA);
#pragma unroll
        for (int d0 = 0; d0 < 4; ++d0) { const float g = a.in[9][32 * d0 + r32];
#pragma unroll
            for (int r = 0; r < 16; ++r) OA[(size_t)(q0w + crow(r, hi)) * 512 + h * 128 + 32 * d0 + r32] = (bf16)f2bf(o[d0][r] * ss[r] * g); }
    }
    ATT_WAIT_BAR(0);
#undef ATT_DMA
}

template <int THRL, int AB3 = 0>
__device__ __forceinline__ void attn_unit3(const Args& a, LAS unsigned char* L, int h, int qt, float lam) {
    const int tid = threadIdx.x, lane = tid & 63, r32 = lane & 31, hi = lane >> 5;
    const int wid = __builtin_amdgcn_readfirstlane(tid >> 6), rg = wid & 3, map = wid >> 2;
    const bf16* PROJ = WSP(const bf16, WS_PROJ);
    const int q0w = qt * 128 + rg * 32, mychunk = 2 * qt + (rg >> 1), nkt = 2 * qt + 2;
    const unsigned lds0 = (unsigned)(uintptr_t)L;
    LAS float* wsf = (LAS float*)(L + LDS_WS) + wid * 64;
    const LAS float* TAB = (const LAS float*)(L + TAB_OFF);
    const float farb2 = TAB[1280 + h];
    const int krow = 8 * wid + (lane >> 3);
    const bf16* ksrc0 = PROJ + (size_t)krow * NPROJ + PC_KA + h * 128 + (((lane & 7) ^ ((krow >> 1) & 7)) * 8);
    const unsigned char* vsrc8 = (const unsigned char*)a.ws + WS_VIMG + (size_t)h * 256 * 8192 + wid * 1024 + lane * 16;
    const unsigned kdst = lds0 + OFF_K + wid * 1024, vdst = lds0 + OFF_V + wid * 1024;
#define ATT_DMA(t, so) do { const size_t ro_ = (size_t)(t) * 64 * NPROJ; \
        glds16(ksrc0 + ro_, (unsigned)__builtin_amdgcn_readfirstlane(kdst + (so))); glds16(ksrc0 + ro_ + 64, (unsigned)__builtin_amdgcn_readfirstlane(kdst + (so) + 8192)); \
        glds16(vsrc8 + (size_t)(t) * 8192, (unsigned)__builtin_amdgcn_readfirstlane(vdst + (so))); } while (0)
    constexpr float PO = 8.f, THRF = 0.5f;
    constexpr bool NO_SM = (AB3 == 1 || AB3 == 7 || AB3 >= 9), NO_MMA = (AB3 == 2 || AB3 == 8 || AB3 >= 9), NO_RD = (AB3 == 4 || AB3 == 12), NO_B = (AB3 >= 6), NO_A = (AB3 == 5), NO_DMA = (AB3 == 10), NO_BAR = (AB3 == 11);
    asm volatile("s_waitcnt vmcnt(0)" ::: "memory");
    ATT_DMA(0, 0); ATT_DMA(1, SLOT);
    bf16x8 qr[4];
    { const bf16* Qw = PROJ + (size_t)(q0w + r32) * NPROJ + PC_QA + h * 128 + map * 64 + hi * 8;
#pragma unroll
      for (int d0 = 0; d0 < 4; ++d0) qr[d0] = *reinterpret_cast<const bf16x8*>(Qw + d0 * 16); }
    asm volatile("" : "+v"(qr[0]), "+v"(qr[1]), "+v"(qr[2]), "+v"(qr[3]));
    float mhat = 0.f, l = 0.f;
    f32x16 o[4];
#pragma unroll
    for (int d0 = 0; d0 < 4; ++d0) o[d0] = f32x16{};
    f32x16 cinF, p0, p1;
#pragma unroll
    for (int r = 0; r < 16; ++r) { cinF[r] = farb2; p0[r] = 0.f; p1[r] = 0.f; }
    int so_cur = 0, so_nn = 2 * SLOT;
    const LAS char* kbase = (const LAS char*)L + OFF_K + map * 8192 + r32 * 128;
    int koff[4];
#pragma unroll
    for (int j = 0; j < 4; ++j) koff[j] = (((2 * j + hi) ^ ((r32 >> 1) & 7)) * 16);
    const LAS char* vbase8 = (const LAS char*)L + OFF_V + (lane >> 5) * 256 + ((lane & 15) >> 1) * 32 + ((lane >> 4) & 1) * 16 + (lane & 1) * 8;
    pg8::i32x8_ pa8, vb8[4];
#pragma unroll
    for (int g = 0; g < 8; ++g) { pa8[g] = 0; vb8[0][g] = 0; vb8[1][g] = 0; vb8[2][g] = 0; vb8[3][g] = 0; }
    bool pend = false;
#define ATT_QK(so) do { const LAS char* kp_ = kbase + (so); bf16x8 kf[8]; \
        _Pragma("unroll") for (int j = 0; j < (NO_RD ? 0 : 4); ++j) { kf[2 * j] = *(const LAS bf16x8*)(kp_ + koff[j]); kf[2 * j + 1] = *(const LAS bf16x8*)(kp_ + koff[j] + 4096); } \
        asm volatile("" : "+v"(kf[0]), "+v"(kf[1]), "+v"(kf[2]), "+v"(kf[3]), "+v"(kf[4]), "+v"(kf[5]), "+v"(kf[6]), "+v"(kf[7])); \
        const f32x16 cin_ = cinF; if (NO_MMA) { p0 = cin_; p1 = cin_; break; } \
        p0 = __builtin_amdgcn_mfma_f32_32x32x16_bf16(kf[0], qr[0], cin_, 0, 0, 0); p1 = __builtin_amdgcn_mfma_f32_32x32x16_bf16(kf[1], qr[0], cin_, 0, 0, 0); \
        _Pragma("unroll") for (int d0 = 1; d0 < 4; ++d0) { p0 = __builtin_amdgcn_mfma_f32_32x32x16_bf16(kf[2 * d0], qr[d0], p0, 0, 0, 0); p1 = __builtin_amdgcn_mfma_f32_32x32x16_bf16(kf[2 * d0 + 1], qr[d0], p1, 0, 0, 0); } } while (0)
#define ATT_VREADS(so) do { if (NO_RD) break; const LAS char* vp_ = vbase8 + (so); \
        _Pragma("unroll") for (int db = 0; db < 4; ++db) _Pragma("unroll") for (int j = 0; j < 4; ++j) { const v2i32_t t_ = vtr8(vp_ + db * 2048 + j * 512); vb8[db][2 * j] = t_[0]; vb8[db][2 * j + 1] = t_[1]; } } while (0)
#define ATT_PV() do { if (NO_MMA) break; asm volatile("s_nop 3" ::: ); \
        _Pragma("unroll") for (int db = 0; db < 4; ++db) asm volatile("v_mfma_scale_f32_32x32x64_f8f6f4 %0, %1, %2, %0, %3, %3 op_sel_hi:[0,0,0]" : "+v"(o[db]) : "v"(pa8), "v"(vb8[db]), "v"(0x7f7f7f7f)); } while (0)
#define ATT_SM(kt_) do { if (NO_SM) { _Pragma("unroll") for (int g = 0; g < 4; ++g) { pa8[g] = pk4_fp8a(p0[4 * g], p0[4 * g + 1], p0[4 * g + 2], p0[4 * g + 3]); pa8[4 + g] = pk4_fp8a(p1[4 * g], p1[4 * g + 1], p1[4 * g + 2], p1[4 * g + 3]); } break; } \
        if (!((kt_) * 64 + 63 - q0w <= -128)) { const LAS float* tb = TAB + h * 320 + 255 + (kt_) * 64 - (q0w + r32) + 4 * hi; \
            _Pragma("unroll") for (int r = 0; r < 16; ++r) { p0[r] += tb[(r & 3) + 8 * (r >> 2)]; p1[r] += tb[32 + (r & 3) + 8 * (r >> 2)]; } } \
        float sacc = 0.f; bool resc = false; \
        float rma = max3f(p0[0], p0[1], p1[0]), rmb = max3f(p0[2], p0[3], p1[1]); rma = max3f(rma, p1[2], p1[3]); \
        _Pragma("unroll") for (int r = 4; r < 16; r += 4) { rma = max3f(rma, p0[r], p0[r + 1]); rmb = max3f(rmb, p0[r + 2], p0[r + 3]); rma = max3f(rma, p1[r], p1[r + 1]); rmb = max3f(rmb, p1[r + 2], p1[r + 3]); } \
        float rm = max3f(rma, rmb, rmb); \
        { auto rr = __builtin_amdgcn_permlane32_swap(__float_as_uint(rm), __float_as_uint(rm), false, false); rm = max3f(__uint_as_float(rr[0]), __uint_as_float(rr[1]), __uint_as_float(rr[1])); } \
        if ((kt_) == 0 || __any(rm > THRF + PO)) { \
            const float dl = ((kt_) == 0) ? rm - PO : fmaxf(rm - PO, 0.f); mhat += dl; \
            _Pragma("unroll") for (int r = 0; r < 16; ++r) { p0[r] -= dl; p1[r] -= dl; } \
            const float f = __builtin_amdgcn_exp2f(-dl); l *= f; if (hi == 0) wsf[r32] = f; resc = ((kt_) != 0); \
            _Pragma("unroll") for (int r = 0; r < 16; ++r) cinF[r] = farb2 - mhat; } \
        _Pragma("unroll") for (int r = 0; r < 16; ++r) { p0[r] = __builtin_amdgcn_exp2f(p0[r]); p1[r] = __builtin_amdgcn_exp2f(p1[r]); sacc += p0[r] + p1[r]; } \
        l += sacc; \
        if (resc) { asm volatile("s_waitcnt lgkmcnt(0)" ::: "memory"); \
            _Pragma("unroll") for (int r = 0; r < 16; ++r) { const float f = wsf[crow(r, hi)]; _Pragma("unroll") for (int d0 = 0; d0 < 4; ++d0) o[d0][r] *= f; } } \
        _Pragma("unroll") for (int g = 0; g < 4; ++g) { pa8[g] = pk4_fp8a(p0[4 * g], p0[4 * g + 1], p0[4 * g + 2], p0[4 * g + 3]); pa8[4 + g] = pk4_fp8a(p1[4 * g], p1[4 * g + 1], p1[4 * g + 2], p1[4 * g + 3]); } } while (0)
    if (map == ATT_AHALF) {
        if (ATT_PRIO) asm volatile("s_setprio 1" ::: );
        for (int kt = 0; kt < nkt; ++kt) {
            if (NO_BAR) { asm volatile("s_waitcnt vmcnt(0) lgkmcnt(0)" ::: "memory"); } else { ATT_WAIT_BAR(0); }
            if (!NO_DMA && kt + 2 < nkt) ATT_DMA(kt + 2, so_nn);
            const int so_nx = (so_cur == 2 * SLOT) ? 0 : so_cur + SLOT;
            if (!NO_A) { if (kt == 0) ATT_QK(so_cur);
            if (kt <= mychunk) { ATT_VREADS(so_cur); ATT_SM(kt); ATT_PV(); }
            if (kt + 1 <= mychunk) ATT_QK(so_nx); }
            so_cur = so_nx; so_nn = (so_nn == 2 * SLOT) ? 0 : so_nn + SLOT;
        }
        if (ATT_PRIO) asm volatile("s_setprio 0" ::: );
    } else {
        for (int kt = 0; kt < nkt; ++kt) {
            if (NO_BAR) { asm volatile("s_waitcnt vmcnt(0) lgkmcnt(0)" ::: "memory"); } else { ATT_WAIT_BAR(0); }
            if (!NO_DMA && kt + 2 < nkt) ATT_DMA(kt + 2, so_nn);
            if (!NO_B) { if (pend) { ATT_PV(); pend = false; }
            if (kt <= mychunk) { ATT_VREADS(so_cur); ATT_QK(so_cur); ATT_SM(kt); pend = true; } }
            so_cur = (so_cur == 2 * SLOT) ? 0 : so_cur + SLOT; so_nn = (so_nn == 2 * SLOT) ? 0 : so_nn + SLOT;
        }
        if (pend) ATT_PV();
    }
    { bf16x8 z_ = {0, 0, 0, 0, 0, 0, 0, 0}; asm volatile("" : "+v"(z_));
      asm volatile("s_nop 3\n\tv_mfma_f32_32x32x16_bf16 %0, %1, %2, %0\n\ts_nop 15\n\ts_nop 15" : "+v"(o[3]) : "v"(z_), "v"(qr[0])); }
#undef ATT_QK
#undef ATT_VREADS
#undef ATT_PV
#undef ATT_SM
    int lane_e = lane; asm volatile("" : "+v"(lane_e));
    const int r32e = lane_e & 31, hie = lane_e >> 5;
    { auto rr = __builtin_amdgcn_permlane32_swap(__float_as_uint(l), __float_as_uint(l), false, false); l = __uint_as_float(rr[0]) + __uint_as_float(rr[1]); }
    if (hie == 0) wsf[32 + r32e] = l;
    asm volatile("s_waitcnt lgkmcnt(0)" ::: "memory");
    float rli[16];
#pragma unroll
    for (int r = 0; r < 16; ++r) rli[r] = 1.f / wsf[32 + crow(r, hie)];
#pragma unroll
    for (int d0 = 0; d0 < 4; ++d0)
#pragma unroll
        for (int r = 0; r < 16; ++r) o[d0][r] *= rli[r];
    ATT_WAIT_BAR(0);
    LAS float* EX = (LAS float*)L + rg * 4096;
    if (map == 1) {
#pragma unroll
        for (int d0 = 0; d0 < 4; ++d0)
#pragma unroll
            for (int r = 0; r < 16; ++r) EX[(d0 * 16 + r) * 64 + lane_e] = o[d0][r]; }
    ATT_WAIT_BAR(0);
    if (map == 0) {
        float ss[16];
#pragma unroll
        for (int r = 0; r < 16; ++r) ss[r] = 0.f;
#pragma unroll
        for (int d0 = 0; d0 < 4; ++d0)
#pragma unroll
            for (int r = 0; r < 16; ++r) { const float x = o[d0][r] - lam * EX[(d0 * 16 + r) * 64 + lane_e]; o[d0][r] = x; ss[r] += x * x; }
#pragma unroll
        for (int r = 0; r < 16; ++r) { float s = ss[r]; s += __shfl_xor(s, 1); s += __shfl_xor(s, 2); s += __shfl_xor(s, 4); s += __shfl_xor(s, 8); s += __shfl_xor(s, 16); ss[r] = rsqrtf(s * (1.f / 128.f) + EPS) * 0.8f; }
        bf16* OA = WSP(bf16, WS_OA);
#pragma unroll
        for (int d0 = 0; d0 < 4; ++d0) { const float g = a.in[9][32 * d0 + r32e];
#pragma unroll
            for (int r = 0; r < 16; ++r) OA[(size_t)(q0w + crow(r, hie)) * 512 + h * 128 + 32 * d0 + r32e] = (bf16)f2bf(o[d0][r] * ss[r] * g); }
    }
    ATT_WAIT_BAR(0);
#undef ATT_DMA
}
struct OneUnit { int pn; __device__ __forceinline__ bool next(int i, pg8::Unit& u) const { if (i > 0) return false; u.pm = 0; u.pn = pn; return true; }
    __device__ __forceinline__ void a_ready(const pg8::Unit&) const {} __device__ __forceinline__ void done(const pg8::Unit&) const {} };
constexpr int CW_Q = 3000;
#ifndef ATT_STAG
#define ATT_STAG false
#endif
template <int ABL = 0>
__device__ __forceinline__ void attn_queue(const Args& a, LAS unsigned char* L, int tid, int qword = 0) {
    float s1 = 0.f, s2 = 0.f;
    for (int i = 0; i < 64; ++i) { s1 += a.in[5][i] * a.in[6][i]; s2 += a.in[7][i] * a.in[8][i]; }
    const float lam = expf(s1) - expf(s2) + 0.2f;
    volatile LAS int* qslot = (volatile LAS int*)(L + MISC_OFF + 64);
    gu32* qh = (gu32*)(a.ws + WS_CTL) + CW_Q + qword;
    for (;;) {
        if (tid == 0) *qslot = (int)__hip_atomic_fetch_add(qh, 1u, RLX_AGENT);
        __syncthreads();
        const int idx = *qslot;
        if (idx >= 512) break;
        if (PV_F8 && ABL >= 20) attn_unit3<8, ABL - 20>(a, L, idx & 3, 127 - (idx >> 2), lam); else if (PV_F8 && ABL == 0 && ATT_COMPL) attn_unit3<8>(a, L, idx & 3, 127 - (idx >> 2), lam); else attn_unit<8, ABL, ATT_STAG>(a, L, idx & 3, 127 - (idx >> 2), lam);
    }
}
}

namespace gdn {
using bf16x8 = __attribute__((ext_vector_type(8))) short;
using f32x4v = __attribute__((ext_vector_type(4))) float;
using u32x4v = __attribute__((ext_vector_type(4))) unsigned;
using u32x2v = __attribute__((ext_vector_type(2))) unsigned;
constexpr int ROWB = 272;
constexpr int HALF_BYTES = 65536, OFF_KN = 0, OFF_QN = 17408, OFF_VN = 34816, OFF_SM = 52224;
constexpr size_t GA_UNIT = 57344, GU_UNIT = 16384;
constexpr int GA_W = 0, GA_QD = 16384, GA_KDT = 32768, GA_QK = 49152;
constexpr size_t WS_GA = 692 * MiB, WS_GU = 748 * MiB, WS_GL = 690 * MiB + 768 * 1024;
constexpr int SBUF = 65536;
__device__ __forceinline__ unsigned cvtpk(float lo, float hi) { typedef float f2 __attribute__((ext_vector_type(2))); typedef __bf16 b2 __attribute__((ext_vector_type(2))); f2 v = {lo, hi}; b2 b = __builtin_convertvector(v, b2); return __builtin_bit_cast(unsigned, b); }
__device__ __forceinline__ f32x4v mfma16(bf16x8 a, bf16x8 b, f32x4v c) { return __builtin_amdgcn_mfma_f32_16x16x32_bf16(a, b, c, 0, 0, 0); }

__device__ __forceinline__ void chunk_units(const Args& a, LAS unsigned char* L, int tid, int G, int bid) {
    const int half = tid >> 8, th = tid & 255, lane = tid & 63, hw = (tid >> 6) & 3, quad = lane >> 4, l15 = lane & 15;
    LAS unsigned char* B = L + half * HALF_BYTES;
    LAS unsigned char* KN = B + OFF_KN; LAS unsigned char* QN = B + OFF_QN; LAS unsigned char* VN = B + OFF_VN;
    LAS float* SMgc = (LAS float*)(B + OFF_SM); LAS float* SMeg = SMgc + 64; LAS float* SMekl = SMgc + 128; LAS float* SMbeta = SMgc + 192;
    LAS float* Lm = (LAS float*)QN;
    const bf16* PROJ = WSP(const bf16, WS_PROJ); const float* cw = a.in[10];
    for (int base = bid * 2; base < 1024; base += G * 2) {
        int u = base + half; if (u > 1023) u = 1023;
        const int h = u >> 8, n = u & 255, t0 = n * 64;
        unsigned char* GAu = a.ws + WS_GA + (size_t)u * GA_UNIT; unsigned char* GUu = a.ws + WS_GU + (size_t)u * GU_UNIT;
        __syncthreads();
#ifndef NO_CONV
        { const int cg = th & 15, rq = th >> 4;
#pragma unroll
          for (int p = 0; p < 3; ++p) {
              float w[4][8];
#pragma unroll
              for (int j = 0; j < 4; ++j) { const f32x4v w0 = *(const f32x4v*)(cw + j * 1536 + 512 * p + h * 128 + 8 * cg), w1 = *(const f32x4v*)(cw + j * 1536 + 512 * p + h * 128 + 8 * cg + 4);
                  w[j][0] = w0[0]; w[j][1] = w0[1]; w[j][2] = w0[2]; w[j][3] = w0[3]; w[j][4] = w1[0]; w[j][5] = w1[1]; w[j][6] = w1[2]; w[j][7] = w1[3]; }
              float in[7][8];
#pragma unroll
              for (int m = 0; m < 7; ++m) { const int tt = t0 + 4 * rq - 3 + m; u32x4v raw = {0u, 0u, 0u, 0u};
                  if (tt >= 0) raw = *(const u32x4v*)(PROJ + (size_t)tt * NPROJ + PC_QB + 512 * p + h * 128 + 8 * cg);
#pragma unroll
                  for (int i = 0; i < 4; ++i) { in[m][2 * i] = bflo(raw[i]); in[m][2 * i + 1] = bfhi(raw[i]); } }
              LAS unsigned char* T = (p == 0) ? QN : (p == 1) ? KN : VN;
#pragma unroll
              for (int r = 0; r < 4; ++r) { float y[8]; float ss = 0.f;
#pragma unroll
                  for (int i = 0; i < 8; ++i) { float acc = 0.f;
#pragma unroll
                      for (int j = 0; j < 4; ++j) acc += w[j][i] * in[r + j][i];
                      y[i] = siluf_(acc); ss += y[i] * y[i]; }
                  if (p < 2) { ss += __shfl_xor(ss, 1); ss += __shfl_xor(ss, 2); ss += __shfl_xor(ss, 4); ss += __shfl_xor(ss, 8);
                      const float rn = rsqrtf(ss + EPS) * (p == 0 ? 0.08838834764831845f : 1.f);
#pragma unroll
                      for (int i = 0; i < 8; ++i) y[i] *= rn; }
                  u32x4v o; o[0] = cvtpk(y[0], y[1]); o[1] = cvtpk(y[2], y[3]); o[2] = cvtpk(y[4], y[5]); o[3] = cvtpk(y[6], y[7]);
                  *(LAS u32x4v*)(T + (4 * rq + r) * ROWB + cg * 16) = o; }
          } }
#endif
        if (hw == 0) { float gi = WSP(const float, WS_GG)[(size_t)(t0 + lane) * 4 + h]; const float be = WSP(const float, WS_GBETA)[(size_t)(t0 + lane) * 4 + h];
#pragma unroll
            for (int o = 1; o < 64; o <<= 1) { const float t = __shfl_up(gi, o); if (lane >= o) gi += t; }
            const float glast = __shfl(gi, 63);
            SMgc[lane] = gi; SMeg[lane] = expf(gi); SMekl[lane] = expf(glast - gi); SMbeta[lane] = be;
            if (lane == 0) ((float*)(a.ws + WS_GL))[u] = expf(glast); }
        __syncthreads();
#pragma unroll
        for (int m = 0; m < 4; ++m) { const int c = hw + 4 * m, ti = c >> 2, kk = c & 3, i = 16 * ti + l15, da = 32 * kk + 4 * quad;
            const u32x2v ra = *(const LAS u32x2v*)(QN + i * ROWB + da * 2), rb = *(const LAS u32x2v*)(QN + i * ROWB + (da + 16) * 2); const float e = SMeg[i];
            u32x4v o; o[0] = cvtpk(bflo(ra[0]) * e, bfhi(ra[0]) * e); o[1] = cvtpk(bflo(ra[1]) * e, bfhi(ra[1]) * e); o[2] = cvtpk(bflo(rb[0]) * e, bfhi(rb[0]) * e); o[3] = cvtpk(bflo(rb[1]) * e, bfhi(rb[1]) * e);
            *(u32x4v*)(GAu + GA_QD + (c * 64 + lane) * 16) = o; }
        { const int ti = hw, i = 16 * ti + l15; const float gci = SMgc[i];
          unsigned pk[4][2];
#pragma unroll
          for (int tj = 0; tj < 4; ++tj) { f32x4v acc = {0.f, 0.f, 0.f, 0.f};
#pragma unroll
              for (int kk = 0; kk < 4; ++kk) { const bf16x8 af = *(const LAS bf16x8*)(KN + (16 * tj + l15) * ROWB + (32 * kk + 8 * quad) * 2), bfr = *(const LAS bf16x8*)(QN + i * ROWB + (32 * kk + 8 * quad) * 2);
                  acc = mfma16(af, bfr, acc); }
              float vv[4];
#pragma unroll
              for (int r = 0; r < 4; ++r) { const int j = 16 * tj + 4 * quad + r; vv[r] = (j <= i) ? acc[r] * __expf(gci - SMgc[j]) : 0.f; }
              pk[tj][0] = cvtpk(vv[0], vv[1]); pk[tj][1] = cvtpk(vv[2], vv[3]); }
#pragma unroll
          for (int kj = 0; kj < 2; ++kj) { u32x4v o; o[0] = pk[2 * kj][0]; o[1] = pk[2 * kj][1]; o[2] = pk[2 * kj + 1][0]; o[3] = pk[2 * kj + 1][1];
              *(u32x4v*)(GAu + GA_QK + ((ti * 2 + kj) * 64 + lane) * 16) = o; } }
#pragma unroll
        for (int m = 0; m < 4; ++m) { const int c = hw + 4 * m, td = c >> 1, kj = c & 1, d = 16 * td + l15; float vv[8];
#pragma unroll
            for (int jj = 0; jj < 8; ++jj) { const int j = 32 * kj + 16 * (jj >> 2) + 4 * quad + (jj & 3); vv[jj] = bf2f(*(const LAS bf16*)(KN + j * ROWB + d * 2)) * SMekl[j]; }
            u32x4v o; o[0] = cvtpk(vv[0], vv[1]); o[1] = cvtpk(vv[2], vv[3]); o[2] = cvtpk(vv[4], vv[5]); o[3] = cvtpk(vv[6], vv[7]);
            *(u32x4v*)(GAu + GA_KDT + (c * 64 + lane) * 16) = o; }
        __syncthreads();
        { const int ti = hw;
#pragma unroll
          for (int tj = 0; tj < 4; ++tj) { if (tj <= ti) { f32x4v acc = {0.f, 0.f, 0.f, 0.f};
#pragma unroll
              for (int kk = 0; kk < 4; ++kk) { const bf16x8 af = *(const LAS bf16x8*)(KN + (16 * ti + l15) * ROWB + (32 * kk + 8 * quad) * 2), bfr = *(const LAS bf16x8*)(KN + (16 * tj + l15) * ROWB + (32 * kk + 8 * quad) * 2);
                  acc = mfma16(af, bfr, acc); }
              const int j = 16 * tj + l15; const float gcj = SMgc[j];
#pragma unroll
              for (int r = 0; r < 4; ++r) { const int i = 16 * ti + 4 * quad + r; Lm[i * 64 + j] = (i > j) ? SMbeta[i] * acc[r] * __expf(SMgc[i] - gcj) : 0.f; } } } }
        __syncthreads();
        float x[64];
#pragma unroll
        for (int i = 0; i < 64; ++i) x[i] = 0.f;
#ifndef NO_SOLVE
        { const bool isw = th >= 128; const LAS unsigned char* T = (isw ? KN : VN) + (th & 127) * 2;
#pragma unroll
          for (int i = 0; i < 64; ++i) { const float egi = SMeg[i]; const float sc = SMbeta[i] * (isw ? egi : 1.f);
              float acc = bf2f(*(const LAS bf16*)(T + i * ROWB)) * sc;
#pragma unroll
              for (int j4 = 0; j4 < (i + 3) / 4; ++j4) { const f32x4v l4 = *(const LAS f32x4v*)(Lm + i * 64 + 4 * j4);
                  acc -= l4[0] * x[4 * j4]; acc -= l4[1] * x[4 * j4 + 1]; acc -= l4[2] * x[4 * j4 + 2]; acc -= l4[3] * x[4 * j4 + 3]; if ((j4 & 3) == 3) asm volatile("" ::: "memory"); }
              asm volatile("" : "+v"(acc) :: "memory"); x[i] = acc; } }
#endif
        if (th < 128) { const int s = th >> 4, e = th & 15;
#pragma unroll
            for (int i4 = 0; i4 < 16; ++i4) { const int ti = i4 >> 2, q4 = i4 & 3; u32x2v o; o[0] = cvtpk(x[4 * i4], x[4 * i4 + 1]); o[1] = cvtpk(x[4 * i4 + 2], x[4 * i4 + 3]);
                *(u32x2v*)(GUu + (size_t)(((s * 4 + ti) * 64 + q4 * 16 + e) * 8)) = o; } }
        __syncthreads();
        if (th >= 128) { const int d = th - 128, kk = d >> 5, dp = d & 31, q4 = (dp >> 2) & 3, jj = 4 * (dp >> 4) + (dp & 3);
#pragma unroll
            for (int i = 0; i < 64; ++i) *(LAS bf16*)(KN + (((i >> 4) * 4 + kk) * 64 + q4 * 16 + (i & 15)) * 16 + jj * 2) = (bf16)f2bf(x[i]); }
        __syncthreads();
#pragma unroll
        for (int m = 0; m < 4; ++m) { const int off = (m * 256 + th) * 16; *(u32x4v*)(GAu + GA_W + off) = *(const LAS u32x4v*)(KN + off); }
    }
}

#define GDN_BAR_LDS() asm volatile("s_waitcnt lgkmcnt(0)\n\ts_barrier" ::: "memory")
#define GDN_BAR_ALL() asm volatile("s_waitcnt vmcnt(0) lgkmcnt(0)\n\ts_barrier" ::: "memory")
template <int MODE = 0>
__device__ __forceinline__ void scan_wg(const Args& a, LAS unsigned char* L, int tid, int h, int half) {
    const int lane = tid & 63, wid = __builtin_amdgcn_readfirstlane(tid >> 6), quad = lane >> 4, l15 = lane & 15;
    const unsigned lds0 = (unsigned)(uintptr_t)L;
    const unsigned char* GAh = a.ws + WS_GA + (size_t)h * 256 * GA_UNIT; const unsigned char* GUh = a.ws + WS_GU + (size_t)h * 256 * GU_UNIT + (size_t)half * 8192;
    const float* GLh = (const float*)(a.ws + WS_GL) + h * 256; bf16* GO = (bf16*)(a.ws + WS_GO);
    LAS float* GLl = (LAS float*)(L + MISC_OFF + 1024);
    if (tid < 256) GLl[tid] = GLh[tid];
    __syncthreads();
    if (wid >= 4) {
#define GDN_LOAD(n, bo) do { for (int p = wid - 4; p < 64; p += 4) { const unsigned char* src = (p < 56) ? GAh + (size_t)(n) * GA_UNIT + p * 1024 + lane * 16 : GUh + (size_t)(n) * GU_UNIT + (p - 56) * 1024 + lane * 16; \
            att::glds16(src, (unsigned)__builtin_amdgcn_readfirstlane(lds0 + (bo) + p * 1024)); } } while (0)
#define GDN_LD(R, n) do { const int n_ = (n) < 256 ? (n) : 255; _Pragma("unroll") for (int m = 0; m < 16; ++m) { const int p = wid - 4 + 4 * m; \
            R[m] = *(const u32x4v*)((p < 56) ? GAh + (size_t)n_ * GA_UNIT + p * 1024 + lane * 16 : GUh + (size_t)n_ * GU_UNIT + (p - 56) * 1024 + lane * 16); } } while (0)
#define GDN_ST(R, bo) do { _Pragma("unroll") for (int m = 0; m < 16; ++m) { const int p = wid - 4 + 4 * m; *(LAS u32x4v*)(L + (bo) + p * 1024 + lane * 16) = R[m]; } } while (0)
#define GDN_DRAIN(c, bo) do { _Pragma("unroll") for (int m = 0; m < 2; ++m) { const int j = (wid - 4) + 4 * m, ch = j >> 1, r = 32 * (j & 1) + (lane >> 1); \
            const u32x4v v = *(const LAS u32x4v*)(L + (bo) + 57344 + j * 1024 + lane * 16); \
            *(u32x4v*)(GO + (size_t)((c) * 64 + r) * 512 + h * 128 + half * 64 + ch * 16 + (lane & 1) * 8) = v; } } while (0)
        u32x4v X[16], Y[16], Z[16];
        GDN_LD(X, 0); GDN_ST(X, 0); GDN_LD(Y, 1); GDN_LD(Z, 2); GDN_LD(X, 3);
#define GDN_STEP(n, R) do { GDN_BAR_LDS(); if (MODE != 1) { if ((n) > 0 && (n) <= 256) GDN_DRAIN((n) - 1, (((n) + 1) & 1) * SBUF); GDN_ST(R, (((n) + 1) & 1) * SBUF); GDN_LD(R, (n) + 4); } } while (0)
        for (int n = 0; n < 258; n += 6) { GDN_STEP(n, Y); GDN_STEP(n + 1, Z); GDN_STEP(n + 2, X); GDN_STEP(n + 3, Y); GDN_STEP(n + 4, Z); GDN_STEP(n + 5, X); }
        GDN_BAR_LDS();
#undef GDN_STEP
#undef GDN_DRAIN
#undef GDN_LD
#undef GDN_ST
#undef GDN_LOAD
    } else {
        const int s = half * 4 + wid;
        f32x4v S[8]; bf16x8 Sb[4];
#pragma unroll
        for (int td = 0; td < 8; ++td) S[td] = (f32x4v){0.f, 0.f, 0.f, 0.f};
#pragma unroll
        for (int kk = 0; kk < 4; ++kk) Sb[kk] = (bf16x8){0, 0, 0, 0, 0, 0, 0, 0};
        for (int n = 0; n < 258; ++n) {
            GDN_BAR_LDS();
            if (MODE == 2 || n >= 256) continue;
            const float gl = GLl[n];
            const LAS unsigned char* Bf = L + (n & 1) * SBUF + lane * 16;
            const LAS unsigned char* Uf = L + (n & 1) * SBUF + 57344 + wid * 2048 + lane * 8;
            f32x4v W[4], O[4];
#pragma unroll
            for (int ti = 0; ti < 4; ++ti) { W[ti] = (f32x4v){0.f, 0.f, 0.f, 0.f}; O[ti] = (f32x4v){0.f, 0.f, 0.f, 0.f}; }
#pragma unroll
            for (int ti = 0; ti < 4; ++ti)
#pragma unroll
                for (int kk = 0; kk < 4; ++kk) W[ti] = mfma16(*(const LAS bf16x8*)(Bf + GA_W + (ti * 4 + kk) * 1024), Sb[kk], W[ti]);
#pragma unroll
            for (int ti = 0; ti < 4; ++ti)
#pragma unroll
                for (int kk = 0; kk < 4; ++kk) O[ti] = mfma16(Sb[kk], *(const LAS bf16x8*)(Bf + GA_QD + (ti * 4 + kk) * 1024), O[ti]);
            f32x4v vn[4];
#pragma unroll
            for (int ti = 0; ti < 4; ++ti) { const u32x2v ur = *(const LAS u32x2v*)(Uf + ti * 512); vn[ti] = (f32x4v){bflo(ur[0]), bfhi(ur[0]), bflo(ur[1]), bfhi(ur[1])} - W[ti]; }
            bf16x8 vnb[2];
#pragma unroll
            for (int kj = 0; kj < 2; ++kj) { u32x4v t; t[0] = cvtpk(vn[2 * kj][0], vn[2 * kj][1]); t[1] = cvtpk(vn[2 * kj][2], vn[2 * kj][3]); t[2] = cvtpk(vn[2 * kj + 1][0], vn[2 * kj + 1][1]); t[3] = cvtpk(vn[2 * kj + 1][2], vn[2 * kj + 1][3]);
                vnb[kj] = __builtin_bit_cast(bf16x8, t); }
#pragma unroll
            for (int td = 0; td < 8; ++td) { S[td] = S[td] * gl;
#pragma unroll
                for (int kj = 0; kj < 2; ++kj) S[td] = mfma16(*(const LAS bf16x8*)(Bf + GA_KDT + (td * 2 + kj) * 1024), vnb[kj], S[td]); }
#pragma unroll
            for (int ti = 0; ti < 4; ++ti)
#pragma unroll
                for (int kj = 0; kj < 2; ++kj) O[ti] = mfma16(vnb[kj], *(const LAS bf16x8*)(Bf + GA_QK + (ti * 2 + kj) * 1024), O[ti]);
#pragma unroll
            for (int kk = 0; kk < 4; ++kk) { u32x4v t; t[0] = cvtpk(S[2 * kk][0], S[2 * kk][1]); t[1] = cvtpk(S[2 * kk][2], S[2 * kk][3]); t[2] = cvtpk(S[2 * kk + 1][0], S[2 * kk + 1][1]); t[3] = cvtpk(S[2 * kk + 1][2], S[2 * kk + 1][3]);
                Sb[kk] = __builtin_bit_cast(bf16x8, t); }
#pragma unroll
            for (int ti = 0; ti < 4; ++ti) { u32x2v o2; o2[0] = cvtpk(O[ti][0], O[ti][1]); o2[1] = cvtpk(O[ti][2], O[ti][3]);
                *(LAS u32x2v*)(L + (n & 1) * SBUF + 57344 + wid * 2048 + (16 * ti + l15) * 32 + quad * 8) = o2; }
        }
        GDN_BAR_LDS();
    }
    asm volatile("s_waitcnt vmcnt(0) lgkmcnt(0)" ::: "memory");
}
}

namespace xat {
using bf16x8 = gdn::bf16x8; using f32x4v = gdn::f32x4v; using u32x4v = gdn::u32x4v; using u32x2v = gdn::u32x2v;
constexpr int SLOT = 32768;
constexpr float CS = 0.0625f * 1.4426950408889634f;
__device__ __forceinline__ void dma_tile(const bf16* KVX, int hh, int ft, unsigned dst, int wid, int lane) {
    if (ft < 4) {
#pragma unroll
        for (int i = 0; i < 4; ++i) { const int c = wid + 8 * i; att::glds16(KVX + (size_t)(64 * ft + lane) * 2048 + hh * 256 + 8 * c, (unsigned)__builtin_amdgcn_readfirstlane(dst + c * 1024)); }
    } else { const int vt = ft - 4;
#pragma unroll
        for (int i = 0; i < 4; ++i) { const int pv = wid + 8 * i, dblk = pv >> 2, kg = pv & 3;
            att::glds16(KVX + (size_t)(64 * vt + 16 * kg + (lane >> 2)) * 2048 + 1024 + hh * 256 + dblk * 32 + (lane & 3) * 8, (unsigned)__builtin_amdgcn_readfirstlane(dst + pv * 1024)); }
    }
}
__device__ __forceinline__ void unit(const Args& a, LAS unsigned char* L, int rb, int hh) {
    const int tid = threadIdx.x, lane = tid & 63, l15 = lane & 15, quad = lane >> 4;
    const int wid = __builtin_amdgcn_readfirstlane(tid >> 6);
    const bf16* QX = WSP(const bf16, WS_QX); const bf16* KVX = WSP(const bf16, WS_KVX); bf16* OX = WSP(bf16, WS_OX);
    const unsigned lds0 = (unsigned)(uintptr_t)L;
    const size_t row = (size_t)rb * 128 + 16 * wid + l15;
    asm volatile("s_waitcnt vmcnt(0)" ::: "memory");
    dma_tile(KVX, hh, 0, lds0, wid, lane); dma_tile(KVX, hh, 1, lds0 + SLOT, wid, lane);
    bf16x8 qr[8];
#pragma unroll
    for (int kk = 0; kk < 8; ++kk) qr[kk] = *(const bf16x8*)(QX + row * DM + hh * 256 + 32 * kk + 8 * quad);
    f32x4v S[16], O[16]; bf16x8 pb[8];
#pragma unroll
    for (int ft = 0; ft < 8; ++ft) {
        if (ft + 1 < 8) { ATT_WAIT_BAR(4); } else { ATT_WAIT_BAR(0); }
        if (ft + 2 < 8) dma_tile(KVX, hh, ft + 2, lds0 + ((ft + 2) % 3) * SLOT, wid, lane);
        const LAS char* sl = (const LAS char*)L + (ft % 3) * SLOT;
        if (ft < 4) {
#pragma unroll
            for (int tk = 0; tk < 4; ++tk) { f32x4v acc = {0.f, 0.f, 0.f, 0.f};
#pragma unroll
                for (int kk = 0; kk < 8; ++kk) acc = gdn::mfma16(*(const LAS bf16x8*)(sl + (4 * kk + quad) * 1024 + (16 * tk + l15) * 16), qr[kk], acc);
                S[4 * ft + tk] = acc; }
            if (ft == 3) {
                float m = S[0][0];
#pragma unroll
                for (int t = 0; t < 16; ++t)
#pragma unroll
                    for (int r = 0; r < 4; ++r) m = fmaxf(m, S[t][r]);
                m = fmaxf(m, __shfl_xor(m, 16)); m = fmaxf(m, __shfl_xor(m, 32));
                const float mc = m * CS; float sum = 0.f;
#pragma unroll
                for (int t = 0; t < 16; ++t)
#pragma unroll
                    for (int r = 0; r < 4; ++r) { const float p = __builtin_amdgcn_exp2f(S[t][r] * CS - mc); S[t][r] = p; sum += p; }
                sum += __shfl_xor(sum, 16); sum += __shfl_xor(sum, 32);
                const float inv = 1.f / sum;
#pragma unroll
                for (int ks = 0; ks < 8; ++ks) { u32x4v t; t[0] = gdn::cvtpk(S[2 * ks][0] * inv, S[2 * ks][1] * inv); t[1] = gdn::cvtpk(S[2 * ks][2] * inv, S[2 * ks][3] * inv);
                    t[2] = gdn::cvtpk(S[2 * ks + 1][0] * inv, S[2 * ks + 1][1] * inv); t[3] = gdn::cvtpk(S[2 * ks + 1][2] * inv, S[2 * ks + 1][3] * inv); pb[ks] = __builtin_bit_cast(bf16x8, t); }
#pragma unroll
                for (int td = 0; td < 16; ++td) O[td] = (f32x4v){0.f, 0.f, 0.f, 0.f};
            }
        } else { const int vt = ft - 4;
            const LAS char* vb = sl + (4 * quad + (l15 >> 2)) * 64 + (l15 & 3) * 8;
#pragma unroll
            for (int td = 0; td < 16; ++td)
#pragma unroll
                for (int kss = 0; kss < 2; ++kss) { const LAS char* p = vb + (td >> 1) * 4096 + (2 * kss) * 1024 + (td & 1) * 32;
                    const att::s16x4 lo = att::vtr(p), hi = att::vtr(p + 1024);
                    const bf16x8 vf = (bf16x8){lo[0], lo[1], lo[2], lo[3], hi[0], hi[1], hi[2], hi[3]};
                    O[td] = gdn::mfma16(vf, pb[2 * vt + kss], O[td]); }
        }
    }
    bf16* orow = OX + row * DM + hh * 256 + 4 * quad;
    if (FP8_X) { unsigned char* o8 = (unsigned char*)OX + row * DM + hh * 256 + 4 * quad;
#pragma unroll
        for (int td = 0; td < 16; ++td) *(unsigned*)(o8 + 16 * td) = pk4_fp8(O[td][0], O[td][1], O[td][2], O[td][3]); }
    else {
#pragma unroll
    for (int td = 0; td < 16; ++td) { u32x2v o; o[0] = gdn::cvtpk(O[td][0], O[td][1]); o[1] = gdn::cvtpk(O[td][2], O[td][3]); *(u32x2v*)(orow + 16 * td) = o; } }
    ATT_WAIT_BAR(0);
}
__device__ __forceinline__ void phase(const Args& a, LAS unsigned char* L, int G, int bid) {
    for (int u = bid; u < 512; u += G) unit(a, L, u >> 2, u & 3);
}
}
struct EpiProj {
    static constexpr bool PERM = true, AFTER_DRAIN = false;
    bf16* O; unsigned char* VI; int pno; float s8;
    __device__ __forceinline__ void operator()(const pg8::f32x4 (&acc)[2][2][4][2], const pg8::Unit& u, int wr, int wc, int fr, int fq) const {
        const int pn = u.pn + pno;
        const int row0 = u.pm * 256 + wr * 64 + fr, col0 = pn * 256 + wc * 32 + 8 * fq;
        if (PV_F8 && (pn == 4 || pn == 5)) {
#pragma unroll
            for (int ai = 0; ai < 2; ++ai)
#pragma unroll
                for (int m = 0; m < 4; ++m)
#pragma unroll
                    for (int bj = 0; bj < 2; ++bj) { const pg8::f32x4 v0 = acc[ai][bj][m][0] * s8, v1 = acc[ai][bj][m][1] * s8;
                        const int tok = row0 + ai * 128 + m * 16, cc = col0 + bj * 128 - PC_VA, hd = cc >> 7, d = cc & 127, key = tok & 63;
                        const int slot = (key & 0x33) | ((key & 4) << 1) | ((key & 8) >> 1);
                        v2u o; o.x = pk4_fp8(v0[0], v0[1], v0[2], v0[3]); o.y = pk4_fp8(v1[0], v1[1], v1[2], v1[3]);
                        *(v2u*)(VI + ((size_t)(hd * 256 + (tok >> 6)) * 8192 + (d >> 5) * 2048 + slot * 32 + (d & 31))) = o; }
            return; } const float sc = ((pn < 2) ? att::C2 : 1.f) * s8; const bool gate = pn >= 14;
#pragma unroll
        for (int ai = 0; ai < 2; ++ai)
#pragma unroll
            for (int m = 0; m < 4; ++m)
#pragma unroll
                for (int bj = 0; bj < 2; ++bj) { pg8::f32x4 v0 = acc[ai][bj][m][0] * sc, v1 = acc[ai][bj][m][1] * sc;
                    if (gate) { v0[0] = sigmoidf_(v0[0]); v0[1] = sigmoidf_(v0[1]); v0[2] = sigmoidf_(v0[2]); v0[3] = sigmoidf_(v0[3]); v1[0] = sigmoidf_(v1[0]); v1[1] = sigmoidf_(v1[1]); v1[2] = sigmoidf_(v1[2]); v1[3] = sigmoidf_(v1[3]); }
                    v4u o; o.x = pg8::cvt_pk_bf16(v0[0], v0[1]); o.y = pg8::cvt_pk_bf16(v0[2], v0[3]); o.z = pg8::cvt_pk_bf16(v1[0], v1[1]); o.w = pg8::cvt_pk_bf16(v1[2], v1[3]);
                    *(v4u*)(O + (size_t)(row0 + ai * 128 + m * 16) * NPROJ + col0 + bj * 128) = o; }
    }
};
#ifndef PHASE_MASK
#define PHASE_MASK 0xFFFFFFFFu
#endif
__global__ void __launch_bounds__(NTHR, 2) mk_fwd(Args a) {
    extern __shared__ __attribute__((aligned(16))) unsigned char lds[];
    LAS unsigned char* L = (LAS unsigned char*)lds;
    const int tid = threadIdx.x, lane = tid & 63, wave = __builtin_amdgcn_readfirstlane(tid >> 6);
    const int G = gridDim.x, bid = blockIdx.x;
    const int gw = bid * NWAVES + wave, NGW = G * NWAVES;
    gu32* ctl = (gu32*)(a.ws + WS_CTL);
    for (int u = tid; u < (LDS_BYTES - MISC_OFF) / 4; u += NTHR) ((LAS unsigned*)(L + MISC_OFF))[u] = 0u;
    __syncthreads();
    const int lo = a.ph_lo, hi = a.ph_hi;
    const bool one = (hi - lo) > 1;
    XcdBarrier bar; bar.bar = (unsigned*)ctl + CW_BAR; bar.x = 0; bar.st = nullptr;
    if (one) bar = xcd_barrier_post((unsigned*)ctl + CW_BAR, (volatile LAS unsigned*)(L + MISC_OFF) + 8);
#define IN(k) (((PHASE_MASK >> (k)) & 1u) && lo <= (k) && (k) < hi)
#define SEAM(k) do { if (IN(k) && IN((k) + 1)) xcd_barrier(bar); } while (0)
#define PH_BEGIN(k) if (IN(k)) { const __attribute__((address_space(4))) Args* ap_ = (const __attribute__((address_space(4))) Args*)__builtin_amdgcn_kernarg_segment_ptr(); asm volatile("" : "+s"(ap_)); const Args& a = *(const Args*)ap_;
#define PH_END(k) } SEAM(k);
    constexpr bool AL = true, SP = true;

    PH_BEGIN(0) phase_prep(a, L, tid, lane, wave, G, bid); PH_END(0)
    PH_BEGIN(1)
        { constexpr int NB = GATE_F8 ? 3072 : NPROJ;
          pg8::Gemm g{WSP(const bf16, WS_H), WSP(const bf16, WS_WT_IN), SEQ, NB, DM}; pg8::StaticOrder S; S.init(SEQ, NB, G, bid);
          EpiProj E{WSP(bf16, WS_PROJ), (unsigned char*)a.ws + WS_VIMG, 0, FP8_IN ? 1.f / W8_SCALE : 1.f}; pg8::gemm_phase<EpiProj, pg8::StaticOrder, AL, SP, false, FP8_IN != 0>(L, g, S, E); }
        if (GATE_F8) { pg8::Gemm g{WSP(const bf16, WS_H8), WSP(const bf16, WS_WT_IN8), SEQ, NPROJ - 3072, DM}; pg8::StaticOrder S; S.init(SEQ, NPROJ - 3072, G, bid);
          EpiProj E{WSP(bf16, WS_PROJ), (unsigned char*)a.ws + WS_VIMG, 12, 1.f / W8_SCALE}; pg8::gemm_phase<EpiProj, pg8::StaticOrder, AL, SP, false, true>(L, g, S, E); }
    PH_END(1)
    PH_BEGIN(2) gdn::chunk_units(a, L, tid, G, bid); PH_END(2)
    PH_BEGIN(3)
        if (bid < 8) { gdn::scan_wg(a, L, tid, bid & 3, bid >> 2);
            __syncthreads();
            if (tid == 0) { __builtin_amdgcn_fence(__ATOMIC_RELEASE, "agent"); xb_add((unsigned*)ctl + CW_SCAN, 1u); } }
        else if (bid < 8 + 32) {
            prep_moe_pf(a, (LAS float*)(L + wave * 16640), lane, (bid - 8) * NWAVES + wave, 32 * NWAVES); }
        if (bid >= G - 8) {
            pg8::Gemm g{WSP(const bf16, WS_MEMN), WSP(const bf16, WS_WT_KV), NMEM, 2048, DM}; att::OneUnit S{bid - (G - 8)};
            pg8::EpiBf16<0> E{WSP(bf16, WS_KVX), 2048, nullptr, 0, 0, 1.f}; pg8::gemm_phase<pg8::EpiBf16<0>, att::OneUnit, AL, SP>(L, g, S, E); }
        __syncthreads();
        att::build_tables(a, L, tid);
        if (bid >= 8) att::attn_queue(a, L, tid);
        { constexpr int TS = 3072;
            if (tid == 0) { unsigned sp = 0; while (xb_ld((unsigned*)ctl + CW_SCAN) < 8u && ++sp < (1u << 22)) __builtin_amdgcn_s_sleep(8); }
            __syncthreads();
            __builtin_amdgcn_fence(__ATOMIC_ACQUIRE, "agent");
            if (bid < 8) phase_gdn_post(a, lane, bid * NWAVES + wave, 8 * NWAVES, 0, TS);
            else phase_gdn_post(a, lane, (bid - 8) * NWAVES + wave, (G - 8) * NWAVES, TS, SEQ); }
#if defined(PROBE_REPEAT3)
        xcd_barrier(bar);
        if (bid < 8) gdn::scan_wg(a, L, tid, bid & 3, bid >> 2);
        __syncthreads();
        att::attn_queue(a, L, tid, 64);
#endif
    PH_END(3)
    PH_BEGIN(5)
#if P5_PAIR
        { static_assert(WS_OB - WS_OA == (size_t)SEQ * 512 * 2 && WS_WT_UPB - WS_WT_UPA == (size_t)1024 * 512 * 2, "the paired unit stream addresses ob / up_b as row panel + 64 / column tile + 4");
          pg8::Gemm g{WSP(const bf16, WS_OA), WSP(const bf16, WS_WT_UPA), SEQ, DM, 512}; PairOrder S; S.S.init(SEQ, DM, G, bid);
          EpiGatePair E{WSP(const bf16, WS_PROJ), WSP(bf16, WS_MRG)}; pg8::gemm_phase<EpiGatePair, PairOrder, AL, SP>(L, g, S, E); }
#else
        { pg8::Gemm g{WSP(const bf16, WS_OA), WSP(const bf16, WS_WT_UPA), SEQ, DM, 512}; pg8::StaticOrder S; S.init(SEQ, DM, G, bid);
          EpiGate<false> E{WSP(const bf16, WS_PROJ), WSP(bf16, WS_MRG)}; pg8::gemm_phase<EpiGate<false>, pg8::StaticOrder, AL, SP>(L, g, S, E); }
        { pg8::Gemm g{WSP(const bf16, WS_OB), WSP(const bf16, WS_WT_UPB), SEQ, DM, 512}; pg8::StaticOrder S; S.init(SEQ, DM, G, bid);
          EpiGate<true> E{WSP(const bf16, WS_PROJ), WSP(bf16, WS_MRG)}; pg8::gemm_phase<EpiGate<true>, pg8::StaticOrder, AL, SP>(L, g, S, E); }
#endif
    PH_END(5)
    PH_BEGIN(6) { pg8::Gemm g{WSP(const bf16, WS_MRG), WSP(const bf16, WS_WT_OUT), SEQ, DM, DM}; pg8::StaticOrder S; S.init(SEQ, DM, G, bid);
        EpiResidStat<false> E{a.in[0], WSP(bf16, WS_XB), WSP(float, WS_SS), FP8_X ? WSP(unsigned char, WS_X8) : nullptr, 1.f}; pg8::gemm_phase<EpiResidStat<false>, pg8::StaticOrder, AL, SP>(L, g, S, E); } PH_END(6)
    PH_BEGIN(7) { pg8::Gemm g{WSP(const bf16, FP8_X ? WS_X8 : WS_H), WSP(const bf16, WS_WT_QX), SEQ, DM, DM}; pg8::StaticOrder S; S.init(SEQ, DM, G, bid);
        EpiRowScale E{WSP(bf16, WS_QX), WSP(const float, WS_SS)}; pg8::gemm_phase<EpiRowScale, pg8::StaticOrder, AL, SP, false, FP8_X != 0>(L, g, S, E); } PH_END(7)
    PH_BEGIN(8) xat::phase(a, L, G, bid); PH_END(8)
    PH_BEGIN(9) { pg8::Gemm g{WSP(const bf16, WS_OX), WSP(const bf16, WS_WT_OX), SEQ, DM, DM}; pg8::StaticOrder S; S.init(SEQ, DM, G, bid);
        EpiResidStat<true> E{nullptr, WSP(bf16, WS_XB), WSP(float, WS_SS), MOE_F8 ? WSP(unsigned char, WS_X8) : nullptr, FP8_X ? 1.f / W8_SCALE : 1.f}; pg8::gemm_phase<EpiResidStat<true>, pg8::StaticOrder, AL, SP, false, FP8_X != 0>(L, g, S, E); } PH_END(9)
    PH_BEGIN(10) if (ROUTER_MFMA) phase_router_mfma(a, L, tid, lane, wave, G, bid, gw, NGW); else phase_router(a, lds, lane, wave, gw, NGW); PH_END(10)
    PH_BEGIN(11) phase_slots(a, lds, tid, lane, wave, G, bid); PH_END(11)
    PH_BEGIN(12) { moe_tables(a, lds, tid, 0); const LAS int* X = (const LAS int*)(L + EXTRA_OFF);
        pg8::Gemm g{WSP(const bf16, MOE_F8 ? WS_X8 : WS_XB), WSP(const bf16, WS_W1T), 0, 0, DM, WSP(const int, WS_SLOTT)}; MoeOrder S{G, bid, 8, X[96] * 8, X + 128};
        EpiSwiglu E{WSP(bf16, WS_ACT), a.in[26], WSP(const float, WS_SLOTR)}; pg8::gemm_phase<EpiSwiglu, MoeOrder, AL, SP, true, MOE_F8 != 0>(L, g, S, E); } PH_END(12)
    PH_BEGIN(13) { moe_tables(a, lds, tid, 0); const LAS int* X = (const LAS int*)(L + EXTRA_OFF);
        pg8::Gemm g{WSP(const bf16, WS_ACT), WSP(const bf16, WS_W2T), 0, 0, DM}; MoeOrder S{G, bid, 4, X[96] * 4, X + 128};
        EpiMoeOut E{WSP(bf16, WS_YS), a.in[28], WSP(const float, WS_SLOTW)}; pg8::gemm_phase<EpiMoeOut, MoeOrder, AL, SP, false, MOE_F8 != 0>(L, g, S, E); } PH_END(13)
    PH_BEGIN(14) phase_final(a, lane, gw, NGW); PH_END(14)
#undef IN
#undef SEAM
}

#ifndef N_LAUNCH_MODE
#define N_LAUNCH_MODE 1
#endif
extern "C" void kernel_launch(void* const* d_in, const int* in_sizes, int n_in, void* d_out, int out_size, void* d_ws, size_t ws_size, hipStream_t stream) {
    static int grid = 0;
    if (grid == 0) {
        if (n_in != 30 || out_size != SEQ * DM || ws_size < WS_END) { fprintf(stderr, "kernel_launch: unexpected shapes (n_in %d out %d ws %zu)\n", n_in, out_size, ws_size); grid = -1; return; }
        int dev = 0, cus = 0;
        if (hipGetDevice(&dev) != hipSuccess || hipDeviceGetAttribute(&cus, hipDeviceAttributeMultiprocessorCount, dev) != hipSuccess) { grid = -1; return; }
        if (hipFuncSetAttribute((const void*)mk_fwd, hipFuncAttributeMaxDynamicSharedMemorySize, LDS_BYTES) != hipSuccess) { fprintf(stderr, "kernel_launch: hipFuncSetAttribute failed\n"); grid = -1; return; }
        int per_cu = 0; (void)hipOccupancyMaxActiveBlocksPerMultiprocessor(&per_cu, (const void*)mk_fwd, NTHR, LDS_BYTES); (void)hipGetLastError();
        grid = cus;
    }
    if (grid < 0) return;
    (void)hipMemsetAsync((char*)d_ws + WS_CTL, 0, CTL_ZERO_BYTES, stream);
    Args a{};
    for (int i = 0; i < 30; ++i) a.in[i] = (const float*)d_in[i];
    a.out = (float*)d_out; a.ws = (unsigned char*)d_ws;
#if N_LAUNCH_MODE
    a.ph_lo = 0; a.ph_hi = NPH; hipLaunchKernelGGL(mk_fwd, dim3(grid), dim3(NTHR), LDS_BYTES, stream, a);
#else
    for (int p = 0; p < NPH; ++p) { a.ph_lo = p; a.ph_hi = p + 1; hipLaunchKernelGGL(mk_fwd, dim3(grid), dim3(NTHR), LDS_BYTES, stream, a); }
#endif
}
```
